# Optimizing an MI355X kernel written in HIP

```python
import math
import jax, jax.numpy as jnp
from jax import lax
import numpy as np

D_MODEL = 2048
BATCH = 4
SEQ = 4096
DEPTH = 1
DEC_BATCH = 32
DEC_SEQ = 64
PAST_LEN = 2048

CHUNK = 64
D_MIX = D_MODEL
D_RWKV = D_MIX // 2
D_S5 = D_MIX - D_RWKV
HEAD_SIZE = 64
N_HEADS = D_RWKV // HEAD_SIZE
DECAY_LORA = 64
AAA_LORA = 64
GATE_LORA = 160
N_SHIFT = 3 * D_RWKV + DECAY_LORA + AAA_LORA + GATE_LORA
N_IN = N_SHIFT + D_S5
S5_GROUP = 16
S5_GROUPS = D_S5 // S5_GROUP
S5_STATE = 64
D_FF = -(-8 * D_MODEL // (3 * 256)) * 256
ALPHA = (2 * DEPTH) ** 0.25
BETA = (8 * DEPTH) ** -0.25
LN_EPS = 1e-5
GN_EPS = 64e-5

kernel_name = 'rwkv7_s5_hymba_streaming_step'


def layer_norm(x, g, b):
    xf = x.astype(jnp.float32)
    mu = xf.mean(-1, keepdims=True)
    var = jnp.square(xf - mu).mean(-1, keepdims=True)
    y = (xf - mu) * lax.rsqrt(var + LN_EPS) * g.astype(jnp.float32) + b.astype(jnp.float32)
    return y.astype(x.dtype)


def wkv7_scan(r, decay, k, v, kk, a, s0):
    def step(s, inp):
        r_t, w_t, k_t, v_t, kk_t, a_t = inp
        sa = jnp.einsum('bhij,bhj->bhi', s, kk_t)
        s = (s * w_t[:, :, None, :]
             - sa[..., None] * (kk_t * a_t)[:, :, None, :]
             + v_t[..., None] * k_t[:, :, None, :])
        return s, jnp.einsum('bhij,bhj->bhi', s, r_t)
    xs = tuple(jnp.moveaxis(t, 1, 0) for t in (r, decay, k, v, kk, a))
    s_last, ys = lax.scan(step, s0, xs)
    return jnp.moveaxis(ys, 0, 1), s_last


def _affine_combine(e1, e2):
    a1, b1 = e1
    a2, b2 = e2
    return a1 * a2, a2 * b1 + b2


def s5_scan(u, lam_bar, b_bar, c_mat, h0):
    bsz, seq = u.shape[:2]
    c = min(CHUNK, seq)
    n_chunks = seq // c
    u_ch = jnp.moveaxis(u.reshape(bsz, n_chunks, c, S5_GROUPS, S5_GROUP), 1, 0)

    def chunk_step(h, u_c):
        bu = jnp.einsum('bcgk,gpk->bcgp', u_c.astype(jnp.complex64), b_bar)
        bu = bu.at[:, 0].add(lam_bar * h)
        dec = jnp.broadcast_to(lam_bar, bu.shape)
        _, hs = lax.associative_scan(_affine_combine, (dec, bu), axis=1)
        y = jnp.einsum('bcgp,gkp->bcgk', hs, c_mat).real
        return hs[:, -1], y

    h_last, ys = lax.scan(chunk_step, h0, u_ch)
    return jnp.moveaxis(ys, 0, 1).reshape(u.shape), h_last


def mixer(xn, shift0, s0, h0, w_in, mu_shift, w0, w_lora_up, a0, a_lora_up, g_lora_up,
          k_k, k_a, r_k, gn_g, gn_b, a_re, a_im, log_dt, b_re, b_im, c_re, c_im,
          s5_d, glu_w, glu_b, w_out):
    f32 = lambda t: t.astype(jnp.float32)
    bsz, seq, _ = xn.shape
    proj = jnp.einsum('bld,de->ble', xn, w_in)
    p_rw = proj[..., :N_SHIFT]
    u = proj[..., N_SHIFT:]
    prev = jnp.concatenate([shift0.astype(p_rw.dtype), p_rw[:, :-1]], axis=1)
    p_s = p_rw + (prev - p_rw) * mu_shift
    new_shift = p_rw[:, -1:]
    o1 = D_RWKV
    o2 = 2 * D_RWKV
    o3 = 3 * D_RWKV
    o4 = o3 + DECAY_LORA
    o5 = o4 + AAA_LORA
    r, k, v, xw, xa, xg = jnp.split(f32(p_s), [o1, o2, o3, o4, o5], axis=-1)
    w = f32(w0) + jnp.tanh(xw) @ f32(w_lora_up)
    w = -jax.nn.softplus(-w) - 0.5
    decay = jnp.exp(-jnp.exp(w))
    a = jax.nn.sigmoid(f32(a0) + xa @ f32(a_lora_up))
    g = jax.nn.sigmoid(xg) @ f32(g_lora_up)
    heads = lambda t: t.reshape(bsz, seq, N_HEADS, HEAD_SIZE)
    kk = heads(k * f32(k_k))
    kk = kk / jnp.maximum(jnp.sqrt(jnp.sum(kk * kk, -1, keepdims=True)), 1e-12)
    k = k * (1.0 + (a - 1.0) * f32(k_a))
    rh, kh, vh = heads(r), heads(k), heads(v)
    yh, s_last = wkv7_scan(rh, heads(decay), kh, vh, kk, heads(a), f32(s0))
    mu = yh.mean(-1, keepdims=True)
    var = jnp.square(yh - mu).mean(-1, keepdims=True)
    yn = ((yh - mu) * lax.rsqrt(var + GN_EPS)).reshape(bsz, seq, D_RWKV) * f32(gn_g) + f32(gn_b)
    bonus = (jnp.sum(rh * kh * f32(r_k), -1, keepdims=True) * vh).reshape(bsz, seq, D_RWKV)
    o_rwkv = (yn + bonus) * g
    dt = jnp.exp(f32(log_dt))[:, None]
    lam = lax.complex(f32(a_re), f32(a_im))
    lam_bar = jnp.exp(lam * dt)
    b_bar = ((lam_bar - 1.0) / lam)[..., None] * lax.complex(f32(b_re), f32(b_im))
    c_mat = lax.complex(f32(c_re), f32(c_im))
    ug = f32(u).reshape(bsz, seq, S5_GROUPS, S5_GROUP)
    ys, h_last = s5_scan(ug, lam_bar, b_bar, c_mat, h0)
    ys = ys + f32(s5_d) * ug
    z = jax.nn.gelu(ys.reshape(bsz, seq, D_S5))
    o_s5 = z * jax.nn.sigmoid(z @ f32(glu_w) + f32(glu_b))
    o = jnp.concatenate([o_rwkv, o_s5], axis=-1).astype(xn.dtype)
    return o @ w_out, new_shift, s_last, h_last


def swiglu(x, w1, w3, w2):
    return (jax.nn.silu(x @ w1) * (x @ w3)) @ w2


def _normal(key, shape, scale):
    return jax.random.normal(key, shape, jnp.float32) * scale


def setup_inputs(seed: int = 0) -> dict:
    key = jax.random.key(seed)
    ks = iter(jax.random.split(key, 48))
    nk = lambda: next(ks)
    f = jnp.float32
    L = DEPTH
    w0_base = jnp.linspace(-6.0, -1.0, D_RWKV, dtype=f)
    a_im_base = math.pi * jnp.arange(S5_STATE, dtype=f)
    return {
        'x_prompt': _normal(nk(), (BATCH, SEQ, D_MODEL), 1.0),
        'x_sample': _normal(nk(), (DEC_BATCH, DEC_SEQ, D_MODEL), 1.0),
        'cache_shift': _normal(nk(), (L, DEC_BATCH, 1, N_SHIFT), 1.0),
        'state_wkv': _normal(nk(), (L, DEC_BATCH, N_HEADS, HEAD_SIZE, HEAD_SIZE), 0.5),
        'state_s5_re': _normal(nk(), (L, DEC_BATCH, S5_GROUPS, S5_STATE), 0.5),
        'state_s5_im': _normal(nk(), (L, DEC_BATCH, S5_GROUPS, S5_STATE), 0.5),
        'ln_in_g': 1.0 + _normal(nk(), (D_MODEL,), 0.02),
        'ln_in_b': _normal(nk(), (D_MODEL,), 0.02),
        'w_in': _normal(nk(), (L, D_MODEL, N_IN), D_MODEL ** -0.5),
        'mu_shift': jax.random.uniform(nk(), (L, N_SHIFT), f, 0.0, 1.0),
        'w0': w0_base + _normal(nk(), (L, D_RWKV), 0.1),
        'w_lora_up': _normal(nk(), (L, DECAY_LORA, D_RWKV), 0.1 * DECAY_LORA ** -0.5),
        'a0': _normal(nk(), (L, D_RWKV), 0.1),
        'a_lora_up': _normal(nk(), (L, AAA_LORA, D_RWKV), 0.1 * AAA_LORA ** -0.5),
        'g_lora_up': _normal(nk(), (L, GATE_LORA, D_RWKV), GATE_LORA ** -0.5),
        'k_k': 0.85 + _normal(nk(), (L, D_RWKV), 0.02),
        'k_a': 1.0 + _normal(nk(), (L, D_RWKV), 0.02),
        'r_k': _normal(nk(), (L, N_HEADS, HEAD_SIZE), 0.1),
        'gn_g': 1.0 + _normal(nk(), (L, D_RWKV), 0.02),
        'gn_b': _normal(nk(), (L, D_RWKV), 0.02),
        's5_a_re': -0.5 + _normal(nk(), (L, S5_GROUPS, S5_STATE), 0.01),
        's5_a_im': a_im_base + _normal(nk(), (L, S5_GROUPS, S5_STATE), 0.01),
        's5_log_dt': jax.random.uniform(nk(), (L, S5_GROUPS), f, math.log(1e-3), math.log(1e-1)),
        's5_b_re': _normal(nk(), (L, S5_GROUPS, S5_STATE, S5_GROUP), (2 * S5_GROUP) ** -0.5),
        's5_b_im': _normal(nk(), (L, S5_GROUPS, S5_STATE, S5_GROUP), (2 * S5_GROUP) ** -0.5),
        's5_c_re': _normal(nk(), (L, S5_GROUPS, S5_GROUP, S5_STATE), (2 * S5_STATE) ** -0.5),
        's5_c_im': _normal(nk(), (L, S5_GROUPS, S5_GROUP, S5_STATE), (2 * S5_STATE) ** -0.5),
        's5_d': _normal(nk(), (L, S5_GROUPS, S5_GROUP), 1.0),
        'glu_w': _normal(nk(), (L, D_S5, D_S5), D_S5 ** -0.5),
        'glu_b': _normal(nk(), (L, D_S5), 0.01),
        'w_out': _normal(nk(), (L, D_MIX, D_MODEL), BETA * D_MIX ** -0.5),
        'ln1_g': 1.0 + _normal(nk(), (L, D_MODEL), 0.02),
        'ln1_b': _normal(nk(), (L, D_MODEL), 0.02),
        'ffn_w1': _normal(nk(), (L, D_MODEL, D_FF), D_MODEL ** -0.5),
        'ffn_w3': _normal(nk(), (L, D_MODEL, D_FF), D_MODEL ** -0.5),
        'ffn_w2': _normal(nk(), (L, D_FF, D_MODEL), BETA * D_FF ** -0.5),
        'ln2_g': 1.0 + _normal(nk(), (L, D_MODEL), 0.02),
        'ln2_b': _normal(nk(), (L, D_MODEL), 0.02),
    }


def reference(x_prompt, x_sample, cache_shift, state_wkv, state_s5_re, state_s5_im,
              ln_in_g, ln_in_b, w_in, mu_shift, w0, w_lora_up, a0, a_lora_up, g_lora_up,
              k_k, k_a, r_k, gn_g, gn_b, s5_a_re, s5_a_im, s5_log_dt, s5_b_re, s5_b_im,
              s5_c_re, s5_c_im, s5_d, glu_w, glu_b, w_out, ln1_g, ln1_b,
              ffn_w1, ffn_w3, ffn_w2, ln2_g, ln2_b):
    assert x_sample.shape[1] <= CHUNK

    def run(x, shift, wkv, h_re, h_im):
        x = layer_norm(x, ln_in_g, ln_in_b)
        outs = []
        for l in range(DEPTH):
            h0 = lax.complex(h_re[l].astype(jnp.float32), h_im[l].astype(jnp.float32))
            mix, n_shift, n_wkv, n_h = mixer(
                x, shift[l], wkv[l], h0, w_in[l], mu_shift[l], w0[l], w_lora_up[l], a0[l],
                a_lora_up[l], g_lora_up[l], k_k[l], k_a[l], r_k[l], gn_g[l], gn_b[l],
                s5_a_re[l], s5_a_im[l], s5_log_dt[l], s5_b_re[l], s5_b_im[l], s5_c_re[l],
                s5_c_im[l], s5_d[l], glu_w[l], glu_b[l], w_out[l])
            x = layer_norm(ALPHA * x + mix, ln1_g[l], ln1_b[l])
            x = layer_norm(ALPHA * x + swiglu(x, ffn_w1[l], ffn_w3[l], ffn_w2[l]), ln2_g[l], ln2_b[l])
            outs.append((n_shift, n_wkv, jnp.real(n_h), jnp.imag(n_h)))
        dt = x.dtype
        stack = lambda i: jnp.stack([o[i] for o in outs]).astype(dt)
        return x, stack(0), stack(1), stack(2), stack(3)

    bp = x_prompt.shape[0]
    dtp = x_prompt.dtype
    y_prompt, shift_p, wkv_p, s5re_p, s5im_p = run(
        x_prompt,
        jnp.zeros((DEPTH, bp, 1, N_SHIFT), dtp),
        jnp.zeros((DEPTH, bp, N_HEADS, HEAD_SIZE, HEAD_SIZE), dtp),
        jnp.zeros((DEPTH, bp, S5_GROUPS, S5_STATE), dtp),
        jnp.zeros((DEPTH, bp, S5_GROUPS, S5_STATE), dtp))
    y_sample, shift_s, wkv_s, s5re_s, s5im_s = run(
        x_sample, cache_shift, state_wkv, state_s5_re, state_s5_im)
    return (y_prompt, y_sample, shift_p, wkv_p, s5re_p, s5im_p, shift_s, wkv_s, s5re_s, s5im_s)
```

```cpp
#include <hip/hip_runtime.h>
#include <hip/hip_cooperative_groups.h>
#include <cstdio>
namespace cg = cooperative_groups;

#define LAS __attribute__((address_space(3)))
typedef unsigned short bf16_t;
typedef short bf16x8 __attribute__((ext_vector_type(8)));
typedef float f32x4 __attribute__((ext_vector_type(4)));
typedef float f32x2 __attribute__((ext_vector_type(2)));
typedef unsigned u32x4 __attribute__((ext_vector_type(4)));
typedef unsigned u32x2 __attribute__((ext_vector_type(2)));

constexpr int T_ALL = 18432, T_PR = 16384, D = 2048, NSH = 3360, NINP = 4608, DR = 1024, DFF = 5632;
constexpr int SEQ_P = 4096, SEQ_S = 64, NB_P = 4, NB_S = 32;
constexpr int LORA_K = 384, LORA_N = 3072;
constexpr float ALPHA = 1.189207115002721f;
constexpr float LN_EPS = 1e-5f, GN_EPS = 64e-5f;
constexpr size_t O_Y = 0, O_SHP = 37748736, O_WKVP = 37762176, O_S5RP = 38024320, O_S5IP = 38040704, O_SHS = 38057088, O_WKVS = 38164608, O_S5RS = 40261760, O_S5IS = 40392832;
constexpr size_t WS_WIN = 0, WS_WLORA = 18874368, WS_WGLU = 21233664, WS_WOUT = 23330816, WS_W13 = 31719424, WS_W2 = 77856768, WS_S5P = 100925440,
                 WS_XN = 101974016, WS_PROJ = 177471488, WS_O = 347340800, WS_Z = 422838272, WS_END = 460587008;
constexpr size_t WS_H = WS_PROJ, WS_LA = WS_O;
constexpr size_t S5_LAM = 0, S5_BB = 32768, S5_CM = 32768 + 262144;
constexpr size_t DO_LOUT = 0, DO_YW = 113246208;
constexpr int LDS_BYTES = 131072;

struct Params {
    const float* in[38];
    float* out;
    unsigned char* ws;
    int ph_lo, ph_hi;
};

__device__ __forceinline__ float bf2f(unsigned b) { return __uint_as_float(b << 16); }
__device__ __forceinline__ unsigned f2bf(float f) { unsigned u = __float_as_uint(f); return (u + 0x7fffu + ((u >> 16) & 1u)) >> 16; }
__device__ __forceinline__ unsigned pk2(float lo, float hi) { unsigned r; asm volatile("v_cvt_pk_bf16_f32 %0, %1, %2" : "=v"(r) : "v"(lo), "v"(hi)); return r; }
__device__ __forceinline__ float lo16(unsigned w) { return __uint_as_float(w << 16); }
__device__ __forceinline__ float hi16(unsigned w) { return __uint_as_float(w & 0xffff0000u); }
__device__ __forceinline__ float sigmoidf_(float x) { return 1.0f / (1.0f + __expf(-x)); }
__device__ __forceinline__ float tanhf_(float x) { return 1.0f - 2.0f / (1.0f + __expf(2.0f * x)); }
__device__ __forceinline__ float wave_sum(float v) {
#pragma unroll
    for (int o = 1; o < 64; o <<= 1) v += __shfl_xor(v, o);
    return v;
}
template <int CTRL> __device__ __forceinline__ float dppf(float x) { return __builtin_bit_cast(float, __builtin_amdgcn_mov_dpp(__builtin_bit_cast(int, x), CTRL, 0xf, 0xf, true)); }
__device__ __forceinline__ float allreduce16(float x) {
    x += dppf<0xB1>(x); x += dppf<0x4E>(x); x += dppf<0x141>(x); x += dppf<0x140>(x); return x;
}

namespace pg8 {
#define PG8_LAS __attribute__((address_space(3)))
typedef unsigned short bf16_t;
typedef short bf16x8 __attribute__((ext_vector_type(8)));
typedef float f32x4 __attribute__((ext_vector_type(4)));
typedef unsigned u32x4 __attribute__((ext_vector_type(4)));
constexpr int BM = 256, BK = 64, HALF = 128, HTB = HALF * BK * 2  , STAGE_BYTES = 8 * HTB, NXCD = 8, WGM = 8;

__host__ __device__ __forceinline__ int lds_byte(int r, int c) { const int st = (r >> 4) * 2 + (c >> 5), rr = r & 15, cc = c & 31, ob = rr * 64 + cc * 2; return st * 1024 + (ob ^ (((ob >> 9) & 1) << 5)); }
__host__ __device__ __forceinline__ void stage_rc(int b, int& R, int& C) { const int st = b / 1024, sb = b % 1024, swz = sb ^ (((sb >> 9) & 1) << 5); R = (st >> 1) * 16 + swz / 64; C = (st & 1) * 32 + (swz % 64) / 2; }
__host__ __device__ __forceinline__ int perm32(int rho) { const int n = rho >> 4, i = rho & 15; return 8 * (i >> 2) + 4 * n + (i & 3); }

struct Unit { int pm, pn; };
struct Gemm { const bf16_t* A; const bf16_t* Bt; int M, N, K; };

struct StaticOrder {
    int nM, nN, nwg, G, c;
    __host__ __device__ void init(int M, int N, int G_, int c_) { nM = M / BM; nN = N / BM; nwg = nM * nN; G = G_; c = c_; }
    __host__ __device__ bool next(int i, Unit& u) const {
        const long L = (long)i * G + c; if (L >= nwg) return false;
        int wgid = (int)L; { const int q = nwg / NXCD, r = nwg % NXCD, xcd = wgid % NXCD, off = wgid / NXCD; wgid = (xcd < r ? xcd * (q + 1) : r * (q + 1) + (xcd - r) * q) + off; }
        const int nig = WGM * nN, gid = wgid / nig, fm = gid * WGM, gsz = (nM - fm) < WGM ? (nM - fm) : WGM;
        u.pm = fm + ((wgid % nig) % gsz); u.pn = (wgid % nig) / gsz; return true;
    }
    __device__ __forceinline__ void a_ready(const Unit&) const {}
    __device__ __forceinline__ void done(const Unit&) const {}
};

template <class Epi, class Sched>
__device__ __forceinline__ void gemm_phase(PG8_LAS unsigned char* lds, const Gemm g, const Sched& S, const Epi& E) {
    const int tid = threadIdx.x, wid = __builtin_amdgcn_readfirstlane(tid >> 6), lane = tid & 63, wr = wid >> 2, wc = wid & 3, fr = lane & 15, fq = lane >> 4;
    const int K = g.K, nt = K / BK;
    unsigned voffA[2], voffB[2];
#pragma unroll
    for (int i = 0; i < 2; ++i) { int R, C; stage_rc(tid * 16 + i * 8192, R, C); const int Rb = Epi::PERM ? ((R & ~31) + perm32(R & 31)) : R;
        voffA[i] = (unsigned)(R * K + C) * 2u; voffB[i] = (unsigned)(Rb * K + C) * 2u; }
    const size_t kstep = (size_t)(BK * 2);
    const size_t hstep = (size_t)HALF * K * 2;
    const size_t tstep = 2 * hstep;
    const unsigned ldsw = (unsigned)wid * 1024u;
    const int aoff = lds_byte(wr * 64 + fr, fq * 8), boff = lds_byte(wc * 32 + fr, fq * 8);
#define PG8_SA(b, h) (((b) * 2 + (h)) * HTB)
#define PG8_SB(b, h) ((4 + (b) * 2 + (h)) * HTB)
#define PG8_STAGE(bufoff, gbase, voff) do { _Pragma("unroll") for (int _i = 0; _i < 2; ++_i) \
        __builtin_amdgcn_global_load_lds((const unsigned*)((const char*)(gbase) + (voff)[_i]), (PG8_LAS unsigned*)(lds + (bufoff) + ldsw + _i * 8192), 16, 0, 0); } while (0)
#define PG8_LDA(dst, b, h) do { _Pragma("unroll") for (int m = 0; m < 4; ++m) _Pragma("unroll") for (int k = 0; k < 2; ++k) dst[m][k] = *(const PG8_LAS bf16x8*)(lds + PG8_SA(b, h) + aoff + m * 2048 + k * 1024); } while (0)
#define PG8_LDB(dst, b, h) do { _Pragma("unroll") for (int n = 0; n < 2; ++n) _Pragma("unroll") for (int k = 0; k < 2; ++k) dst[n][k] = *(const PG8_LAS bf16x8*)(lds + PG8_SB(b, h) + boff + n * 2048 + k * 1024); } while (0)
#define PG8_MMA(ai, bj, At, Bt) do { __builtin_amdgcn_s_setprio(1); _Pragma("unroll") for (int m = 0; m < 4; ++m) _Pragma("unroll") for (int n = 0; n < 2; ++n) _Pragma("unroll") for (int k = 0; k < 2; ++k) \
        acc[ai][bj][m][n] = __builtin_amdgcn_mfma_f32_16x16x32_bf16(Bt[n][k], At[m][k], acc[ai][bj][m][n], 0, 0, 0); __builtin_amdgcn_s_setprio(0); } while (0)
#define PG8_WAIT_V(n) asm volatile("s_waitcnt vmcnt(" #n ")" ::: "memory")
#define PG8_WAIT_L(n) asm volatile("s_waitcnt lgkmcnt(" #n ")" ::: "memory")
#define PG8_BAR __builtin_amdgcn_s_barrier()
#define PG8_SCHED __builtin_amdgcn_sched_barrier(0)
    Unit cur, nxt; int ui = 0;
    if (!S.next(0, cur)) return;
    f32x4 acc[2][2][4][2];
#pragma unroll
    for (int a = 0; a < 2; ++a)
#pragma unroll
        for (int b = 0; b < 2; ++b)
#pragma unroll
            for (int m = 0; m < 4; ++m)
#pragma unroll
                for (int n = 0; n < 2; ++n) acc[a][b][m][n] = (f32x4){0.f, 0.f, 0.f, 0.f};
    bf16x8 At[4][2], B0[2][2], B1[2][2];
    const char* cA = (const char*)g.A + (size_t)cur.pm * tstep; const char* cB = (const char*)g.Bt + (size_t)cur.pn * tstep;
    S.a_ready(cur);
    PG8_STAGE(PG8_SB(0, 0), cB, voffB); PG8_STAGE(PG8_SA(0, 0), cA, voffA); PG8_STAGE(PG8_SB(0, 1), cB + hstep, voffB); PG8_STAGE(PG8_SA(0, 1), cA + hstep, voffA);
    if (wr == 1) PG8_BAR;
    PG8_WAIT_V(4); PG8_BAR;
    PG8_STAGE(PG8_SB(1, 0), cB + kstep, voffB); PG8_STAGE(PG8_SA(1, 0), cA + kstep, voffA); PG8_STAGE(PG8_SB(1, 1), cB + hstep + kstep, voffB);
    PG8_WAIT_V(6); PG8_BAR;
    for (;;) {
        const bool has_next = S.next(ui + 1, nxt);
        const char* nA = has_next ? (const char*)g.A + (size_t)nxt.pm * tstep : cA; const char* nB = has_next ? (const char*)g.Bt + (size_t)nxt.pn * tstep : cB;
        for (int t = 0; t < nt; t += 2) {
            const bool last = (t == nt - 2);
            const char* a1 = cA + (size_t)(t + 1) * kstep;
            const char* a2 = last ? nA : cA + (size_t)(t + 2) * kstep; const char* b2 = last ? nB : cB + (size_t)(t + 2) * kstep;
            const char* a3 = a2 + kstep; const char* b3 = b2 + kstep;
            if (last && has_next) S.a_ready(nxt);
            PG8_LDB(B0, 0, 0); PG8_SCHED; PG8_LDA(At, 0, 0); PG8_STAGE(PG8_SA(1, 1), a1 + hstep, voffA);
            PG8_WAIT_L(8); PG8_BAR; PG8_WAIT_L(0); PG8_MMA(0, 0, At, B0); PG8_BAR; PG8_SCHED;
            PG8_LDB(B1, 0, 1); PG8_STAGE(PG8_SB(0, 0), b2, voffB);
            PG8_BAR; PG8_WAIT_L(0); PG8_MMA(0, 1, At, B1); PG8_BAR;
            PG8_LDA(At, 0, 1); PG8_STAGE(PG8_SA(0, 0), a2, voffA);
            PG8_BAR; PG8_WAIT_L(0); PG8_MMA(1, 0, At, B0); PG8_BAR; PG8_SCHED;
            PG8_STAGE(PG8_SB(0, 1), b2 + hstep, voffB);
            PG8_WAIT_V(6); PG8_BAR; PG8_MMA(1, 1, At, B1); PG8_BAR;
            PG8_LDB(B0, 1, 0); PG8_SCHED; PG8_LDA(At, 1, 0); PG8_STAGE(PG8_SA(0, 1), a2 + hstep, voffA);
            PG8_WAIT_L(8); PG8_BAR; PG8_WAIT_L(0); PG8_MMA(0, 0, At, B0); PG8_BAR; PG8_SCHED;
            PG8_LDB(B1, 1, 1); PG8_STAGE(PG8_SB(1, 0), b3, voffB);
            PG8_BAR; PG8_WAIT_L(0); PG8_MMA(0, 1, At, B1); PG8_BAR;
            PG8_LDA(At, 1, 1); PG8_STAGE(PG8_SA(1, 0), a3, voffA);
            PG8_BAR; PG8_WAIT_L(0); PG8_MMA(1, 0, At, B0); PG8_BAR; PG8_SCHED;
            PG8_STAGE(PG8_SB(1, 1), b3 + hstep, voffB);
            PG8_WAIT_V(6); PG8_BAR; PG8_MMA(1, 1, At, B1); PG8_BAR;
        }
        if constexpr (!Epi::AFTER_DRAIN) { E(acc, cur, wr, wc, fr, fq); S.done(cur); }
        if (!has_next) break;
#pragma unroll
        for (int a = 0; a < 2; ++a)
#pragma unroll
            for (int b = 0; b < 2; ++b)
#pragma unroll
                for (int m = 0; m < 4; ++m)
#pragma unroll
                    for (int n = 0; n < 2; ++n) acc[a][b][m][n] = (f32x4){0.f, 0.f, 0.f, 0.f};
        cur = nxt; cA = nA; cB = nB; ++ui;
    }
    PG8_WAIT_V(0);
    if (wr == 0) PG8_BAR;
    PG8_BAR;
    if constexpr (Epi::AFTER_DRAIN) { E.fused(acc, cur, wr, wc, fr, fq, lds, wid, lane); S.done(cur); }
#undef PG8_SA
#undef PG8_SB
#undef PG8_STAGE
#undef PG8_LDA
#undef PG8_LDB
#undef PG8_MMA
#undef PG8_WAIT_V
#undef PG8_WAIT_L
#undef PG8_BAR
#undef PG8_SCHED
}
}


using pg8::Unit;
typedef f32x4 AccT[2][2][4][2];

struct EpiProj {
    static constexpr bool PERM = true, AFTER_DRAIN = false;
    bf16_t* P; float* out;
    __device__ __forceinline__ void operator()(const AccT& acc, const Unit& u, int wr, int wc, int fr, int fq) const {
        const int row0 = u.pm * 256 + wr * 64 + fr, col0 = u.pn * 256 + wc * 32 + 8 * fq;
#pragma unroll
        for (int ai = 0; ai < 2; ++ai)
#pragma unroll
            for (int m = 0; m < 4; ++m) {
                const int r = row0 + ai * 128 + m * 16;
                const bool last = r < T_PR ? ((r & (SEQ_P - 1)) == SEQ_P - 1) : ((r & (SEQ_S - 1)) == SEQ_S - 1);
#pragma unroll
                for (int bj = 0; bj < 2; ++bj) {
                    const int c = col0 + bj * 128; const f32x4 v0 = acc[ai][bj][m][0], v1 = acc[ai][bj][m][1];
                    u32x4 w; w.x = pk2(v0[0], v0[1]); w.y = pk2(v0[2], v0[3]); w.z = pk2(v1[0], v1[1]); w.w = pk2(v1[2], v1[3]);
                    *(u32x4*)(P + (size_t)r * NINP + c) = w;
                    if (last && c < NSH) {
                        float* o = r < T_PR ? out + O_SHP + (size_t)(r >> 12) * NSH + c : out + O_SHS + (size_t)((r - T_PR) >> 6) * NSH + c;
                        *(f32x4*)o = v0; *(f32x4*)(o + 4) = v1;
                    }
                }
            }
    }
};
struct EpiBf {
    static constexpr bool PERM = true, AFTER_DRAIN = false;
    bf16_t* P; int ld;
    __device__ __forceinline__ void operator()(const AccT& acc, const Unit& u, int wr, int wc, int fr, int fq) const {
        const int row0 = u.pm * 256 + wr * 64 + fr, col0 = u.pn * 256 + wc * 32 + 8 * fq;
#pragma unroll
        for (int ai = 0; ai < 2; ++ai)
#pragma unroll
            for (int m = 0; m < 4; ++m) {
                const int r = row0 + ai * 128 + m * 16;
#pragma unroll
                for (int bj = 0; bj < 2; ++bj) {
                    const int c = col0 + bj * 128; const f32x4 v0 = acc[ai][bj][m][0], v1 = acc[ai][bj][m][1];
                    u32x4 w; w.x = pk2(v0[0], v0[1]); w.y = pk2(v0[2], v0[3]); w.z = pk2(v1[0], v1[1]); w.w = pk2(v1[2], v1[3]);
                    *(u32x4*)(P + (size_t)r * ld + c) = w;
                }
            }
    }
};
struct EpiGlu {
    static constexpr bool PERM = true, AFTER_DRAIN = false;
    const bf16_t* Z; bf16_t* O; const float* bias;
    __device__ __forceinline__ void operator()(const AccT& acc, const Unit& u, int wr, int wc, int fr, int fq) const {
        const int row0 = u.pm * 256 + wr * 64 + fr, col0 = u.pn * 256 + wc * 32 + 8 * fq;
        f32x4 bv[2][2];
#pragma unroll
        for (int bj = 0; bj < 2; ++bj) { bv[bj][0] = *(const f32x4*)(bias + col0 + bj * 128); bv[bj][1] = *(const f32x4*)(bias + col0 + bj * 128 + 4); }
#pragma unroll
        for (int ai = 0; ai < 2; ++ai)
#pragma unroll
            for (int m = 0; m < 4; ++m) {
                const int r = row0 + ai * 128 + m * 16;
#pragma unroll
                for (int bj = 0; bj < 2; ++bj) {
                    const int c = col0 + bj * 128; const f32x4 v0 = acc[ai][bj][m][0] + bv[bj][0], v1 = acc[ai][bj][m][1] + bv[bj][1];
                    const u32x4 z = *(const u32x4*)(Z + (size_t)r * DR + c);
                    u32x4 w;
                    w.x = pk2(lo16(z.x) * sigmoidf_(v0[0]), hi16(z.x) * sigmoidf_(v0[1]));
                    w.y = pk2(lo16(z.y) * sigmoidf_(v0[2]), hi16(z.y) * sigmoidf_(v0[3]));
                    w.z = pk2(lo16(z.z) * sigmoidf_(v1[0]), hi16(z.z) * sigmoidf_(v1[1]));
                    w.w = pk2(lo16(z.w) * sigmoidf_(v1[2]), hi16(z.w) * sigmoidf_(v1[3]));
                    *(u32x4*)(O + (size_t)r * D + DR + c) = w;
                }
                asm volatile("" ::: "memory");
            }
    }
};
struct EpiRes {
    static constexpr bool PERM = false, AFTER_DRAIN = false;
    const bf16_t* X; float* Y;
    __device__ __forceinline__ void operator()(const AccT& acc, const Unit& u, int wr, int wc, int fr, int fq) const {
        const int row0 = u.pm * 256 + wr * 64 + fr, col0 = u.pn * 256 + wc * 32 + 4 * fq;
#pragma unroll
        for (int ai = 0; ai < 2; ++ai)
#pragma unroll
            for (int m = 0; m < 4; ++m) {
                const size_t off = (size_t)(row0 + ai * 128 + m * 16) * D + col0;
#pragma unroll
                for (int bj = 0; bj < 2; ++bj)
#pragma unroll
                    for (int n = 0; n < 2; ++n) {
                        const u32x2 x = *(const u32x2*)(X + off + bj * 128 + n * 16);
                        f32x4 o = acc[ai][bj][m][n];
                        o[0] += ALPHA * lo16(x.x); o[1] += ALPHA * hi16(x.x); o[2] += ALPHA * lo16(x.y); o[3] += ALPHA * hi16(x.y);
                        *(f32x4*)(Y + off + bj * 128 + n * 16) = o;
                    }
                asm volatile("" ::: "memory");
            }
    }
};
struct EpiFfn1 {
    static constexpr bool PERM = false, AFTER_DRAIN = false;
    bf16_t* H;
    __device__ __forceinline__ void operator()(const AccT& acc, const Unit& u, int wr, int wc, int fr, int fq) const {
        const int row0 = u.pm * 256 + wr * 64 + fr, col0 = u.pn * 128 + wc * 16 + 4 * fq;
#pragma unroll
        for (int ai = 0; ai < 2; ++ai)
#pragma unroll
            for (int m = 0; m < 4; ++m) {
                bf16_t* rowp = H + (size_t)(row0 + ai * 128 + m * 16) * DFF + col0;
#pragma unroll
                for (int bj = 0; bj < 2; ++bj) {
                    const f32x4 a1 = acc[ai][bj][m][0], a3 = acc[ai][bj][m][1];
                    float h[4];
#pragma unroll
                    for (int e = 0; e < 4; ++e) h[e] = a1[e] * sigmoidf_(a1[e]) * a3[e];
                    u32x2 w; w.x = pk2(h[0], h[1]); w.y = pk2(h[2], h[3]);
                    *(u32x2*)(rowp + bj * 64) = w;
                }
            }
    }
};

__device__ __forceinline__ bool is_first(int t) { return t < T_PR ? ((t & (SEQ_P - 1)) == 0) : ((t & (SEQ_S - 1)) == 0); }

template <int MODE>
__device__ __forceinline__ void transpose_item(const float* __restrict__ W, int K, int N, bf16_t* __restrict__ WT, LAS float* scr, int item, int lane) {
    const int nblk = N / 32, kb = item / nblk, nb = item % nblk, k0 = 64 * kb, n0 = 32 * nb;
#pragma unroll 8
    for (int i = 0; i < 32; ++i) { const int kk = 2 * i + (lane >> 5); scr[kk * 33 + (lane & 31)] = W[(size_t)(k0 + kk) * N + n0 + (lane & 31)]; }
    asm volatile("s_waitcnt lgkmcnt(0)" ::: "memory");
    const int c = lane & 7;
#pragma unroll
    for (int j = 0; j < 4; ++j) {
        const int n = (lane >> 3) + 8 * j; const LAS float* s = scr + (8 * c) * 33 + n;
        u32x4 o; o.x = pk2(s[0 * 33], s[1 * 33]); o.y = pk2(s[2 * 33], s[3 * 33]); o.z = pk2(s[4 * 33], s[5 * 33]); o.w = pk2(s[6 * 33], s[7 * 33]);
        const int drow = MODE == 0 ? (n0 + n) : (2 * n0 + 32 * (n >> 4) + (n & 15) + (MODE == 2 ? 16 : 0));
        *(u32x4*)(WT + (size_t)drow * K + k0 + 8 * c) = o;
    }
    asm volatile("s_waitcnt lgkmcnt(0)" ::: "memory");
}

__device__ __forceinline__ void ln_row(const float* __restrict__ xrow, const float* __restrict__ g, const float* __restrict__ b, bf16_t* orow, float* frow, int lane) {
    f32x4 v[8]; float s = 0.f;
#pragma unroll
    for (int j = 0; j < 8; ++j) { v[j] = *(const f32x4*)(xrow + 256 * j + 4 * lane); s += (v[j][0] + v[j][1]) + (v[j][2] + v[j][3]); }
    const float mean = wave_sum(s) * (1.f / D); float s2 = 0.f;
#pragma unroll
    for (int j = 0; j < 8; ++j) { v[j] = v[j] - mean; s2 += (v[j][0] * v[j][0] + v[j][1] * v[j][1]) + (v[j][2] * v[j][2] + v[j][3] * v[j][3]); }
    const float rstd = 1.f / sqrtf(wave_sum(s2) * (1.f / D) + LN_EPS);
#pragma unroll
    for (int j = 0; j < 8; ++j) {
        const f32x4 gg = *(const f32x4*)(g + 256 * j + 4 * lane), bb = *(const f32x4*)(b + 256 * j + 4 * lane);
        const f32x4 o = v[j] * rstd * gg + bb;
        if (orow) { u32x2 w; w.x = pk2(o[0], o[1]); w.y = pk2(o[2], o[3]); *(u32x2*)(orow + 256 * j + 4 * lane) = w; }
        if (frow) *(f32x4*)(frow + 256 * j + 4 * lane) = o;
    }
}

__device__ void phase_prep(const Params& p, LAS unsigned char* lds) {
    const int tid = threadIdx.x, lane = tid & 63, wave = tid >> 6;
    const int gw = blockIdx.x * 8 + wave, NGW = gridDim.x * 8;
    const int gt = blockIdx.x * 512 + tid, NGT = gridDim.x * 512;
    unsigned char* ws = p.ws;
    LAS float* scr = (LAS float*)(lds + wave * 8448);
    bf16_t* WIN = (bf16_t*)(ws + WS_WIN); bf16_t* WGLU = (bf16_t*)(ws + WS_WGLU); bf16_t* WOUT = (bf16_t*)(ws + WS_WOUT);
    bf16_t* W13 = (bf16_t*)(ws + WS_W13); bf16_t* W2 = (bf16_t*)(ws + WS_W2); bf16_t* WLORA = (bf16_t*)(ws + WS_WLORA);
    constexpr int I_IN = 32 * 137, I_GLU = 16 * 32, I_OUT = 32 * 64, I_W1 = 32 * 176, I_W2 = 88 * 64;
    constexpr int NITEMS = I_IN + I_GLU + I_OUT + 2 * I_W1 + I_W2;
    for (int it = gw; it < NITEMS; it += NGW) {
        int r = it;
        if (r < I_IN) { transpose_item<0>(p.in[8], D, 4384, WIN, scr, r, lane); continue; } r -= I_IN;
        if (r < I_GLU) { transpose_item<0>(p.in[28], DR, DR, WGLU, scr, r, lane); continue; } r -= I_GLU;
        if (r < I_OUT) { transpose_item<0>(p.in[30], D, D, WOUT, scr, r, lane); continue; } r -= I_OUT;
        if (r < I_W1) { transpose_item<1>(p.in[33], D, DFF, W13, scr, r, lane); continue; } r -= I_W1;
        if (r < I_W1) { transpose_item<2>(p.in[34], D, DFF, W13, scr, r, lane); continue; } r -= I_W1;
        transpose_item<0>(p.in[35], DFF, D, W2, scr, r, lane);
    }
    for (int i = gt; i < (NINP - 4384) * D / 8; i += NGT) *(u32x4*)(WIN + (size_t)4384 * D + (size_t)i * 8) = (u32x4){0u, 0u, 0u, 0u};
    for (int i = gt; i < LORA_N * LORA_K; i += NGT) {
        const int n = i / LORA_K, k = i - n * LORA_K; float v = 0.f;
        if (n < 1024) { if (k < 64) v = p.in[11][(size_t)k * 1024 + n]; }
        else if (n < 2048) { if (k >= 64 && k < 128) v = p.in[13][(size_t)(k - 64) * 1024 + (n - 1024)]; }
        else { if (k >= 128 && k < 288) v = p.in[14][(size_t)(k - 128) * 1024 + (n - 2048)]; }
        WLORA[i] = (bf16_t)f2bf(v);
    }
    bf16_t* XN = (bf16_t*)(ws + WS_XN);
    for (int t = gw; t < T_ALL; t += NGW) {
        const float* xr = t < T_PR ? p.in[0] + (size_t)t * D : p.in[1] + (size_t)(t - T_PR) * D;
        ln_row(xr, p.in[6], p.in[7], XN + (size_t)t * D, nullptr, lane);
    }
    if (gt < 4096) {
        const int g = gt >> 6, pp = gt & 63;
        const double dt = exp((double)p.in[22][g]);
        const double ar = (double)p.in[20][gt], ai = (double)p.in[21][gt];
        const double er = exp(ar * dt); double th = ai * dt;
        const double TWO_PI = 6.283185307179586476925286766559;
        th -= TWO_PI * rint(th / TWO_PI);
        double sn = th, cs = 1.0, term_s = th, term_c = 1.0; const double t2 = th * th;
        for (int k = 1; k < 16; ++k) { term_c *= -t2 / (double)((2 * k - 1) * (2 * k)); cs += term_c; term_s *= -t2 / (double)((2 * k) * (2 * k + 1)); sn += term_s; }
        const double lr = er * cs, li = er * sn;
        float* LAM = (float*)(ws + WS_S5P + S5_LAM);
        LAM[2 * gt] = (float)lr; LAM[2 * gt + 1] = (float)li;
        const double den = ar * ar + ai * ai, xr_ = lr - 1.0, xi_ = li;
        const double qr = (xr_ * ar + xi_ * ai) / den, qi = (xi_ * ar - xr_ * ai) / den;
        bf16_t* BB = (bf16_t*)(ws + WS_S5P + S5_BB) + (size_t)g * 128 * 16;
        bf16_t* CM = (bf16_t*)(ws + WS_S5P + S5_CM) + (size_t)g * 16 * 128;
        for (int k = 0; k < 16; ++k) {
            const double br = (double)p.in[23][(size_t)gt * 16 + k], bi = (double)p.in[24][(size_t)gt * 16 + k];
            BB[(2 * pp) * 16 + k] = (bf16_t)f2bf((float)(qr * br - qi * bi));
            BB[(2 * pp + 1) * 16 + k] = (bf16_t)f2bf((float)(qr * bi + qi * br));
            CM[k * 128 + 2 * pp] = (bf16_t)f2bf(p.in[25][((size_t)g * 16 + k) * 64 + pp]);
            CM[k * 128 + 2 * pp + 1] = (bf16_t)f2bf(-p.in[26][((size_t)g * 16 + k) * 64 + pp]);
        }
    }
}

__device__ void phase_la(const Params& p) {
    const int gt = blockIdx.x * 512 + threadIdx.x, NGT = gridDim.x * 512;
    const bf16_t* PROJ = (const bf16_t*)(p.ws + WS_PROJ); bf16_t* LA = (bf16_t*)(p.ws + WS_LA);
    const float* mu = p.in[9]; const float* cshift = p.in[2];
    for (int i = gt; i < T_ALL * 48; i += NGT) {
        const int t = i / 48, c8 = (i - t * 48) * 8;
        u32x4 o = (u32x4){0u, 0u, 0u, 0u};
        if (c8 < 288) {
            const int col = 3072 + c8;
            const u32x4 cur = *(const u32x4*)(PROJ + (size_t)t * NINP + col);
            float pv[8], cv[8];
            cv[0] = lo16(cur.x); cv[1] = hi16(cur.x); cv[2] = lo16(cur.y); cv[3] = hi16(cur.y); cv[4] = lo16(cur.z); cv[5] = hi16(cur.z); cv[6] = lo16(cur.w); cv[7] = hi16(cur.w);
            if (!is_first(t)) {
                const u32x4 pr = *(const u32x4*)(PROJ + (size_t)(t - 1) * NINP + col);
                pv[0] = lo16(pr.x); pv[1] = hi16(pr.x); pv[2] = lo16(pr.y); pv[3] = hi16(pr.y); pv[4] = lo16(pr.z); pv[5] = hi16(pr.z); pv[6] = lo16(pr.w); pv[7] = hi16(pr.w);
            } else if (t >= T_PR) {
                const float* cs = cshift + (size_t)((t - T_PR) >> 6) * NSH + col;
#pragma unroll
                for (int e = 0; e < 8; ++e) pv[e] = cs[e];
            } else {
#pragma unroll
                for (int e = 0; e < 8; ++e) pv[e] = 0.f;
            }
            float r[8];
#pragma unroll
            for (int e = 0; e < 8; ++e) {
                const float ps = cv[e] + (pv[e] - cv[e]) * mu[col + e];
                r[e] = c8 < 64 ? tanhf_(ps) : (c8 < 128 ? ps : sigmoidf_(ps));
            }
            o.x = pk2(r[0], r[1]); o.y = pk2(r[2], r[3]); o.z = pk2(r[4], r[5]); o.w = pk2(r[6], r[7]);
        }
        *(u32x4*)(LA + (size_t)t * LORA_K + c8) = o;
    }
}

constexpr int WK_BUF = 11264, WK_YB = 2 * WK_BUF;
struct WkvRaw { unsigned r[5], k[5], v[5], dw[4], da[4]; float p_r, p_k, p_v; };

__device__ __forceinline__ void wkv_task(const Params& p, LAS float* L, int tok0, int len, int h, int half, const float* s0, float* sout, const float* shift0) {
    const int tid = threadIdx.x, lane = tid & 63, wave = tid >> 6;
    const int irow = tid >> 4, j4 = tid & 15, i = half * 32 + irow;
    const bf16_t* PROJ = (const bf16_t*)(p.ws + WS_PROJ);
    const bf16_t* LOUT = (const bf16_t*)((const unsigned char*)p.out + DO_LOUT);
    bf16_t* YW = (bf16_t*)((unsigned char*)p.out + DO_YW);
    const int cr = h * 64 + lane, ck = 1024 + cr, cv = 2048 + cr;
    const float mu_r = p.in[9][cr], mu_k = p.in[9][ck], mu_v = p.in[9][cv];
    const float w0c = p.in[10][cr], a0c = p.in[12][cr], kkc = p.in[15][cr], kac = p.in[16][cr];
    f32x4 S = (f32x4){0.f, 0.f, 0.f, 0.f};
    if (s0) S = *(const f32x4*)(s0 + (size_t)i * 64 + 4 * j4);
    const int nch = len / 32;
    WkvRaw raw;

    auto stage_load = [&](int c) {
        const int tq = tok0 + c * 32 + wave * 4;
#pragma unroll
        for (int q = 0; q < 5; ++q) {
            const int t = tq + q - 1;
            if (q == 0 && t < tok0) {
                raw.r[0] = raw.k[0] = raw.v[0] = 0u;
                raw.p_r = shift0 ? shift0[cr] : 0.f; raw.p_k = shift0 ? shift0[ck] : 0.f; raw.p_v = shift0 ? shift0[cv] : 0.f;
            } else {
                const bf16_t* row = PROJ + (size_t)t * NINP;
                raw.r[q] = row[cr]; raw.k[q] = row[ck]; raw.v[q] = row[cv];
                if (q == 0) { raw.p_r = raw.p_k = raw.p_v = 0.f; }
            }
        }
#pragma unroll
        for (int q = 0; q < 4; ++q) { const bf16_t* lr = LOUT + (size_t)(tq + q) * LORA_N; raw.dw[q] = lr[cr]; raw.da[q] = lr[1024 + cr]; }
    };
    auto stage_write = [&](int c, LAS float* B) {
        const bool firstrow = (c == 0 && wave == 0);
#pragma unroll
        for (int q = 0; q < 4; ++q) {
            const int tt = wave * 4 + q;
            const float c_r = bf2f(raw.r[q + 1]), c_k = bf2f(raw.k[q + 1]), c_v = bf2f(raw.v[q + 1]);
            float pr = bf2f(raw.r[q]), pk = bf2f(raw.k[q]), pv = bf2f(raw.v[q]);
            if (q == 0 && firstrow) { pr = raw.p_r; pk = raw.p_k; pv = raw.p_v; }
            const float r = c_r + (pr - c_r) * mu_r, kx = c_k + (pk - c_k) * mu_k, v = c_v + (pv - c_v) * mu_v;
            const float wv = w0c + bf2f(raw.dw[q]);
            const float y = -wv;
            const float sp = fmaxf(y, 0.f) + __logf(1.f + __expf(-fabsf(y)));
            const float decay = __expf(-__expf(-sp - 0.5f));
            const float a = sigmoidf_(a0c + bf2f(raw.da[q]));
            const float kkv = kx * kkc;
            const float ss = wave_sum(kkv * kkv);
            const float kk = kkv / fmaxf(sqrtf(ss), 1e-12f);
            const float kp = kx * (1.f + (a - 1.f) * kac);
            B[tt * 64 + lane] = decay; B[2048 + tt * 64 + lane] = kk; B[4096 + tt * 64 + lane] = -kk * a; B[6144 + tt * 64 + lane] = kp; B[8192 + tt * 64 + lane] = r;
            if ((lane >> 5) == half) B[10240 + tt * 32 + (lane & 31)] = v;
        }
    };

    stage_load(0); stage_write(0, L);
    __syncthreads();
    for (int c = 0; c < nch; ++c) {
        LAS float* B = L + (c & 1) * WK_BUF; LAS float* YB = L + WK_YB + (c & 1) * 1024;
        const bool more = (c + 1 < nch);
        if (more) stage_load(c + 1);
#pragma unroll 8
        for (int t = 0; t < 32; ++t) {
            const f32x4 w = *(const LAS f32x4*)(B + t * 64 + 4 * j4), kk = *(const LAS f32x4*)(B + 2048 + t * 64 + 4 * j4), nb = *(const LAS f32x4*)(B + 4096 + t * 64 + 4 * j4),
                        kv = *(const LAS f32x4*)(B + 6144 + t * 64 + 4 * j4), rv = *(const LAS f32x4*)(B + 8192 + t * 64 + 4 * j4);
            const float v = B[10240 + t * 32 + irow];
            float sa = (S[0] * kk[0] + S[1] * kk[1]) + (S[2] * kk[2] + S[3] * kk[3]);
            sa = allreduce16(sa);
            S = S * w + (v * kv + sa * nb);
            float y = (S[0] * rv[0] + S[1] * rv[1]) + (S[2] * rv[2] + S[3] * rv[3]);
            y = allreduce16(y);
            if (j4 == 0) YB[t * 32 + irow] = y;
        }
        if (more) stage_write(c + 1, L + ((c + 1) & 1) * WK_BUF);
        __syncthreads();
        {
            const int t = tid >> 4, i2 = (tid & 15) * 2;
            const f32x2 yy = *(const LAS f32x2*)(YB + t * 32 + i2);
            *(unsigned*)(YW + (size_t)(tok0 + c * 32 + t) * DR + h * 64 + half * 32 + i2) = pk2(yy[0], yy[1]);
        }
    }
    *(f32x4*)(sout + (size_t)i * 64 + 4 * j4) = S;
    __syncthreads();
}

__device__ __forceinline__ float gelu_tanh(float y) { const float u = 0.7978845608028654f * (y + 0.044715f * y * y * y); return 0.5f * y * (1.f + tanhf_(u)); }

__device__ __forceinline__ void s5_task(const Params& p, LAS unsigned char* wl, int tok0, int len, int g, const float* h0r, const float* h0i, float* outr, float* outi) {
    const int lane = threadIdx.x & 63, fr = lane & 15, fq = lane >> 4;
    LAS float* bufF = (LAS float*)wl;
    LAS unsigned* hb = (LAS unsigned*)(wl + 8448);
    const bf16_t* PROJ = (const bf16_t*)(p.ws + WS_PROJ);
    bf16_t* Z = (bf16_t*)(p.ws + WS_Z);
    const bf16_t* BB = (const bf16_t*)(p.ws + WS_S5P + S5_BB) + (size_t)g * 128 * 16;
    const bf16_t* CM = (const bf16_t*)(p.ws + WS_S5P + S5_CM) + (size_t)g * 16 * 128;
    const float* LAM = (const float*)(p.ws + WS_S5P + S5_LAM) + (size_t)(g * 64 + lane) * 2;
    const bf16x8 zero8 = (bf16x8){0, 0, 0, 0, 0, 0, 0, 0};
    bf16x8 bb[8], cm[4];
#pragma unroll
    for (int nb = 0; nb < 8; ++nb) bb[nb] = fq < 2 ? *(const bf16x8*)(BB + (nb * 16 + fr) * 16 + fq * 8) : zero8;
#pragma unroll
    for (int kk = 0; kk < 4; ++kk) cm[kk] = *(const bf16x8*)(CM + fr * 128 + kk * 32 + fq * 8);
    const float lr = LAM[0], li = LAM[1];
    const f32x4 dv = *(const f32x4*)(p.in[27] + g * 16 + fq * 4);
    float hr = h0r ? h0r[lane] : 0.f, hi = h0i ? h0i[lane] : 0.f;
    const int ntile = len / 16;
    const size_t ucol = NSH + g * 16;
    bf16x8 uf = fq < 2 ? *(const bf16x8*)(PROJ + (size_t)(tok0 + fr) * NINP + ucol + fq * 8) : zero8;
    u32x2 ud = *(const u32x2*)(PROJ + (size_t)(tok0 + fr) * NINP + ucol + fq * 4);
    for (int tile = 0; tile < ntile; ++tile) {
        const int t0 = tok0 + tile * 16;
        const bf16x8 ufc = uf; const u32x2 udc = ud;
        if (tile + 1 < ntile) {
            uf = fq < 2 ? *(const bf16x8*)(PROJ + (size_t)(t0 + 16 + fr) * NINP + ucol + fq * 8) : zero8;
            ud = *(const u32x2*)(PROJ + (size_t)(t0 + 16 + fr) * NINP + ucol + fq * 4);
        }
#pragma unroll
        for (int nb = 0; nb < 8; ++nb) {
            const f32x4 a = __builtin_amdgcn_mfma_f32_16x16x32_bf16(bb[nb], ufc, (f32x4){0.f, 0.f, 0.f, 0.f}, 0, 0, 0);
            *(LAS f32x4*)(bufF + fr * 132 + nb * 16 + fq * 4) = a;
        }
        asm volatile("s_waitcnt lgkmcnt(0)" ::: "memory");
#pragma unroll
        for (int t = 0; t < 16; ++t) {
            const f32x2 bu = *(const LAS f32x2*)(bufF + t * 132 + 2 * lane);
            const float nr = (lr * hr - li * hi) + bu[0], ni = (lr * hi + li * hr) + bu[1];
            hr = nr; hi = ni;
            hb[t * 68 + lane] = pk2(hr, hi);
        }
        asm volatile("s_waitcnt lgkmcnt(0)" ::: "memory");
        f32x4 y = (f32x4){0.f, 0.f, 0.f, 0.f};
#pragma unroll
        for (int kk = 0; kk < 4; ++kk) {
            const bf16x8 hf = *(const LAS bf16x8*)(hb + fr * 68 + kk * 16 + fq * 4);
            y = __builtin_amdgcn_mfma_f32_16x16x32_bf16(cm[kk], hf, y, 0, 0, 0);
        }
        asm volatile("s_waitcnt lgkmcnt(0)" ::: "memory");
        y[0] += dv[0] * lo16(udc.x); y[1] += dv[1] * hi16(udc.x); y[2] += dv[2] * lo16(udc.y); y[3] += dv[3] * hi16(udc.y);
        u32x2 zz; zz.x = pk2(gelu_tanh(y[0]), gelu_tanh(y[1])); zz.y = pk2(gelu_tanh(y[2]), gelu_tanh(y[3]));
        *(u32x2*)(Z + (size_t)(t0 + fr) * DR + g * 16 + fq * 4) = zz;
    }
    outr[lane] = hr; outi[lane] = hi;
}

__device__ void phase_scan(const Params& p, LAS unsigned char* lds) {
    const int blk = blockIdx.x, wave = threadIdx.x >> 6;
    LAS float* L = (LAS float*)lds;
    if (blk < 128) {
        const int b = blk >> 5, h = (blk >> 1) & 15, half = blk & 1;
        wkv_task(p, L, b * SEQ_P, SEQ_P, h, half, nullptr, p.out + O_WKVP + (size_t)(b * 16 + h) * 4096, nullptr);
    } else {
        for (int s = blk - 128; s < 1024; s += (int)gridDim.x - 128) {
            const int b = s >> 5, h = (s >> 1) & 15, half = s & 1;
            wkv_task(p, L, T_PR + b * SEQ_S, SEQ_S, h, half, p.in[3] + (size_t)(b * 16 + h) * 4096, p.out + O_WKVS + (size_t)(b * 16 + h) * 4096, p.in[2] + (size_t)b * NSH);
        }
        const int nb2 = (int)gridDim.x - 128, k = blk - 128;
        LAS unsigned char* wl = lds + wave * 12800;
        if (wave < 2) {
            for (int id = k * 2 + wave; id < 256; id += nb2 * 2) {
                const int b = id >> 6, g = id & 63;
                s5_task(p, wl, b * SEQ_P, SEQ_P, g, nullptr, nullptr, p.out + O_S5RP + (size_t)id * 64, p.out + O_S5IP + (size_t)id * 64);
            }
        } else {
            for (int id = k * 6 + (wave - 2); id < 2048; id += nb2 * 6) {
                const int b = id >> 6, g = id & 63;
                s5_task(p, wl, T_PR + b * SEQ_S, SEQ_S, g, p.in[4] + (size_t)id * 64, p.in[5] + (size_t)id * 64, p.out + O_S5RS + (size_t)id * 64, p.out + O_S5IS + (size_t)id * 64);
            }
        }
    }
}

__device__ void phase_post(const Params& p) {
    const int lane = threadIdx.x & 63, gw = blockIdx.x * 8 + (threadIdx.x >> 6), NGW = gridDim.x * 8;
    const bf16_t* PROJ = (const bf16_t*)(p.ws + WS_PROJ);
    const bf16_t* LOUT = (const bf16_t*)((const unsigned char*)p.out + DO_LOUT);
    const bf16_t* YW = (const bf16_t*)((const unsigned char*)p.out + DO_YW);
    bf16_t* O = (bf16_t*)(p.ws + WS_O);
    for (int it = gw; it < T_ALL * 16; it += NGW) {
        const int t = it >> 4, h = it & 15;
        const int cr = h * 64 + lane, ck = 1024 + cr, cv = 2048 + cr;
        const bf16_t* row = PROJ + (size_t)t * NINP;
        const float c_r = bf2f(row[cr]), c_k = bf2f(row[ck]), c_v = bf2f(row[cv]);
        float pr, pk, pv;
        if (!is_first(t)) { const bf16_t* prow = row - NINP; pr = bf2f(prow[cr]); pk = bf2f(prow[ck]); pv = bf2f(prow[cv]); }
        else if (t >= T_PR) { const float* cs = p.in[2] + (size_t)((t - T_PR) >> 6) * NSH; pr = cs[cr]; pk = cs[ck]; pv = cs[cv]; }
        else { pr = pk = pv = 0.f; }
        const float r = c_r + (pr - c_r) * p.in[9][cr], kx = c_k + (pk - c_k) * p.in[9][ck], v = c_v + (pv - c_v) * p.in[9][cv];
        const bf16_t* lrow = LOUT + (size_t)t * LORA_N;
        const float a = sigmoidf_(p.in[12][cr] + bf2f(lrow[1024 + cr]));
        const float g = bf2f(lrow[2048 + cr]);
        const float kp = kx * (1.f + (a - 1.f) * p.in[16][cr]);
        const float bonus = wave_sum(r * kp * p.in[17][cr]) * v;
        const float y = bf2f(YW[(size_t)t * DR + cr]);
        const float mean = wave_sum(y) * (1.f / 64.f);
        const float d = y - mean;
        const float var = wave_sum(d * d) * (1.f / 64.f);
        const float yn = d * (1.f / sqrtf(var + GN_EPS)) * p.in[18][cr] + p.in[19][cr];
        O[(size_t)t * D + cr] = (bf16_t)f2bf((yn + bonus) * g);
    }
}

__device__ void phase_ln(const float* Y, const float* g, const float* b, bf16_t* xo, float* fo) {
    const int lane = threadIdx.x & 63, gw = blockIdx.x * 8 + (threadIdx.x >> 6), NGW = gridDim.x * 8;
    for (int t = gw; t < T_ALL; t += NGW) ln_row(Y + (size_t)t * D, g, b, xo ? xo + (size_t)t * D : nullptr, fo ? fo + (size_t)t * D : nullptr, lane);
}

constexpr int N_PHASES = 12;
__global__ void __launch_bounds__(512, 2) fwd_kernel(Params p) {
    extern __shared__ __attribute__((aligned(16))) unsigned char shm[];
    LAS unsigned char* lds = (LAS unsigned char*)shm;
    cg::grid_group grid = cg::this_grid();
    unsigned char* ws = p.ws;
    const int lo = p.ph_lo, hi = p.ph_hi;
#define IN(k) (lo <= (k) && (k) < hi)
#define SEAM(k) do { if (IN(k) && IN((k) + 1)) grid.sync(); } while (0)
    bf16_t* XN = (bf16_t*)(ws + WS_XN); bf16_t* PROJ = (bf16_t*)(ws + WS_PROJ); bf16_t* O = (bf16_t*)(ws + WS_O); bf16_t* Z = (bf16_t*)(ws + WS_Z);
    bf16_t* H = (bf16_t*)(ws + WS_H); bf16_t* LA = (bf16_t*)(ws + WS_LA);
    bf16_t* LOUT = (bf16_t*)((unsigned char*)p.out + DO_LOUT);
    const int G = (int)gridDim.x, c = (int)blockIdx.x;

    if (IN(0)) { phase_prep(p, lds); } SEAM(0);
    if (IN(1)) {
        pg8::Gemm g{XN, (const bf16_t*)(ws + WS_WIN), T_ALL, NINP, D}; pg8::StaticOrder S; S.init(T_ALL, NINP, G, c);
        EpiProj E{PROJ, p.out}; pg8::gemm_phase<EpiProj, pg8::StaticOrder>(lds, g, S, E);
    } SEAM(1);
    if (IN(2)) { phase_la(p); } SEAM(2);
    if (IN(3)) {
        pg8::Gemm g{LA, (const bf16_t*)(ws + WS_WLORA), T_ALL, LORA_N, LORA_K}; pg8::StaticOrder S; S.init(T_ALL, LORA_N, G, c);
        EpiBf E{LOUT, LORA_N}; pg8::gemm_phase<EpiBf, pg8::StaticOrder>(lds, g, S, E);
    } SEAM(3);
    if (IN(4)) { phase_scan(p, lds); } SEAM(4);
    if (IN(5)) { phase_post(p); } SEAM(5);
    if (IN(6)) {
        pg8::Gemm g{Z, (const bf16_t*)(ws + WS_WGLU), T_ALL, DR, DR}; pg8::StaticOrder S; S.init(T_ALL, DR, G, c);
        EpiGlu E{Z, O, p.in[29]}; pg8::gemm_phase<EpiGlu, pg8::StaticOrder>(lds, g, S, E);
    } SEAM(6);
    if (IN(7)) {
        pg8::Gemm g{O, (const bf16_t*)(ws + WS_WOUT), T_ALL, D, D}; pg8::StaticOrder S; S.init(T_ALL, D, G, c);
        EpiRes E{XN, p.out}; pg8::gemm_phase<EpiRes, pg8::StaticOrder>(lds, g, S, E);
    } SEAM(7);
    if (IN(8)) { phase_ln(p.out, p.in[31], p.in[32], XN, nullptr); } SEAM(8);
    if (IN(9)) {
        pg8::Gemm g{XN, (const bf16_t*)(ws + WS_W13), T_ALL, 2 * DFF, D}; pg8::StaticOrder S; S.init(T_ALL, 2 * DFF, G, c);
        EpiFfn1 E{H}; pg8::gemm_phase<EpiFfn1, pg8::StaticOrder>(lds, g, S, E);
    } SEAM(9);
    if (IN(10)) {
        pg8::Gemm g{H, (const bf16_t*)(ws + WS_W2), T_ALL, D, DFF}; pg8::StaticOrder S; S.init(T_ALL, D, G, c);
        EpiRes E{XN, p.out}; pg8::gemm_phase<EpiRes, pg8::StaticOrder>(lds, g, S, E);
    } SEAM(10);
    if (IN(11)) { phase_ln(p.out, p.in[36], p.in[37], nullptr, p.out); }
#undef IN
#undef SEAM
}

#ifndef N_LAUNCHES
#define N_LAUNCHES 1
#endif
extern "C" void kernel_launch(void* const* d_in, const int* in_sizes, int n_in, void* d_out, int out_size, void* d_ws, size_t ws_size, hipStream_t stream) {
    static int ready = 0;
    if (!ready) {
        if (hipFuncSetAttribute((const void*)fwd_kernel, hipFuncAttributeMaxDynamicSharedMemorySize, LDS_BYTES) != hipSuccess) fprintf(stderr, "kernel_launch: hipFuncSetAttribute failed\n");
        int per_cu = 0; (void)hipOccupancyMaxActiveBlocksPerMultiprocessor(&per_cu, (const void*)fwd_kernel, 512, LDS_BYTES);
        if (per_cu < 1) fprintf(stderr, "kernel_launch: occupancy query says %d blocks per CU\n", per_cu);
        if (ws_size < WS_END) fprintf(stderr, "kernel_launch: workspace too small: %zu < %zu\n", ws_size, (size_t)WS_END);
        (void)hipGetLastError();
        ready = 1;
    }
    Params p{};
    for (int i = 0; i < 38; ++i) p.in[i] = (const float*)d_in[i];
    p.out = (float*)d_out; p.ws = (unsigned char*)d_ws;
    if (N_LAUNCHES == 1) {
        p.ph_lo = 0; p.ph_hi = N_PHASES;
        void* args[] = {&p};
        hipError_t e = hipLaunchCooperativeKernel((const void*)fwd_kernel, dim3(256), dim3(512), args, LDS_BYTES, stream);
        if (e != hipSuccess) fprintf(stderr, "kernel_launch: cooperative launch failed: %s\n", hipGetErrorString(e));
    } else {
        for (int ph = 0; ph < N_PHASES; ++ph) {
            p.ph_lo = ph; p.ph_hi = ph + 1;
            hipLaunchKernelGGL(fwd_kernel, dim3(256), dim3(512), LDS_BYTES, stream, p);
        }
    }
}
```

```cpp
#include <hip/hip_runtime.h>
#include <hip/hip_cooperative_groups.h>
#include <cstdio>
namespace cg = cooperative_groups;

#define LAS __attribute__((address_space(3)))
typedef unsigned short bf16_t;
typedef short bf16x8 __attribute__((ext_vector_type(8)));
typedef float f32x4 __attribute__((ext_vector_type(4)));
typedef float f32x2 __attribute__((ext_vector_type(2)));
typedef unsigned u32x4 __attribute__((ext_vector_type(4)));
typedef unsigned u32x2 __attribute__((ext_vector_type(2)));

constexpr int T_ALL = 18432, T_PR = 16384, D = 2048, NSH = 3360, NINP = 4608, DR = 1024, DFF = 5632;
constexpr int SEQ_P = 4096, SEQ_S = 64, NB_P = 4, NB_S = 32;
constexpr int LORA_K = 384, LORA_N = 3072;
constexpr float ALPHA = 1.189207115002721f;
constexpr float LN_EPS = 1e-5f, GN_EPS = 64e-5f;
constexpr size_t O_Y = 0, O_SHP = 37748736, O_WKVP = 37762176, O_S5RP = 38024320, O_S5IP = 38040704, O_SHS = 38057088, O_WKVS = 38164608, O_S5RS = 40261760, O_S5IS = 40392832;
constexpr size_t WS_WIN = 0, WS_WLORA = 18874368, WS_WGLU = 21233664, WS_WOUT = 23330816, WS_W13 = 31719424, WS_W2 = 77856768, WS_S5P = 100925440,
                 WS_XN = 101974016, WS_PROJ = 177471488, WS_O = 347340800, WS_Z = 422838272, WS_YW = 460587008, WS_END = 498335744;
constexpr size_t WS_H = WS_PROJ, WS_LA = WS_O;
constexpr size_t S5_LAM = 0, S5_BB = 32768, S5_CM = 32768 + 262144;
constexpr size_t DO_DEC = 0, DO_A = 75497472, DO_G = 113246208;
constexpr int LDS_BYTES = 131072;

struct Params {
    const float* in[38];
    float* out;
    unsigned char* ws;
    int ph_lo, ph_hi, rep, pad;
};

__device__ __forceinline__ float bf2f(unsigned b) { return __uint_as_float(b << 16); }
__device__ __forceinline__ unsigned f2bf(float f) { unsigned u = __float_as_uint(f); return (u + 0x7fffu + ((u >> 16) & 1u)) >> 16; }
__device__ __forceinline__ unsigned pk2(float lo, float hi) { unsigned r; asm volatile("v_cvt_pk_bf16_f32 %0, %1, %2" : "=v"(r) : "v"(lo), "v"(hi)); return r; }
__device__ __forceinline__ float lo16(unsigned w) { return __uint_as_float(w << 16); }
__device__ __forceinline__ float hi16(unsigned w) { return __uint_as_float(w & 0xffff0000u); }
__device__ __forceinline__ float sigmoidf_(float x) { return 1.0f / (1.0f + __expf(-x)); }
__device__ __forceinline__ float tanhf_(float x) { return 1.0f - 2.0f / (1.0f + __expf(2.0f * x)); }
__device__ __forceinline__ float wave_sum(float v) {
#pragma unroll
    for (int o = 1; o < 64; o <<= 1) v += __shfl_xor(v, o);
    return v;
}
template <int CTRL> __device__ __forceinline__ float dppf(float x) { return __builtin_bit_cast(float, __builtin_amdgcn_mov_dpp(__builtin_bit_cast(int, x), CTRL, 0xf, 0xf, true)); }
__device__ __forceinline__ float allreduce16(float x) {
    x += dppf<0xB1>(x); x += dppf<0x4E>(x); x += dppf<0x141>(x); x += dppf<0x140>(x); return x;
}

namespace pg8 {
#define PG8_LAS __attribute__((address_space(3)))
typedef unsigned short bf16_t;
typedef short bf16x8 __attribute__((ext_vector_type(8)));
typedef float f32x4 __attribute__((ext_vector_type(4)));
typedef unsigned u32x4 __attribute__((ext_vector_type(4)));
constexpr int BM = 256, BK = 64, HALF = 128, HTB = HALF * BK * 2  , STAGE_BYTES = 8 * HTB, NXCD = 8, WGM = 8;

__host__ __device__ __forceinline__ int lds_byte(int r, int c) { const int st = (r >> 4) * 2 + (c >> 5), rr = r & 15, cc = c & 31, ob = rr * 64 + cc * 2; return st * 1024 + (ob ^ (((ob >> 9) & 1) << 5)); }
__host__ __device__ __forceinline__ void stage_rc(int b, int& R, int& C) { const int st = b / 1024, sb = b % 1024, swz = sb ^ (((sb >> 9) & 1) << 5); R = (st >> 1) * 16 + swz / 64; C = (st & 1) * 32 + (swz % 64) / 2; }
__host__ __device__ __forceinline__ int perm32(int rho) { const int n = rho >> 4, i = rho & 15; return 8 * (i >> 2) + 4 * n + (i & 3); }

struct Unit { int pm, pn; };
struct Gemm { const bf16_t* A; const bf16_t* Bt; int M, N, K; };

struct StaticOrder {
    int nM, nN, nwg, G, c;
    __host__ __device__ void init(int M, int N, int G_, int c_) { nM = M / BM; nN = N / BM; nwg = nM * nN; G = G_; c = c_; }
    __host__ __device__ bool next(int i, Unit& u) const {
        const long L = (long)i * G + c; if (L >= nwg) return false;
        int wgid = (int)L; { const int q = nwg / NXCD, r = nwg % NXCD, xcd = wgid % NXCD, off = wgid / NXCD; wgid = (xcd < r ? xcd * (q + 1) : r * (q + 1) + (xcd - r) * q) + off; }
        const int nig = WGM * nN, gid = wgid / nig, fm = gid * WGM, gsz = (nM - fm) < WGM ? (nM - fm) : WGM;
        u.pm = fm + ((wgid % nig) % gsz); u.pn = (wgid % nig) / gsz; return true;
    }
    __device__ __forceinline__ void a_ready(const Unit&) const {}
    __device__ __forceinline__ void done(const Unit&) const {}
};

template <class Epi, class Sched>
__device__ __forceinline__ void gemm_phase(PG8_LAS unsigned char* lds, const Gemm g, const Sched& S, const Epi& E) {
    const int tid = threadIdx.x, wid = __builtin_amdgcn_readfirstlane(tid >> 6), lane = tid & 63, wr = wid >> 2, wc = wid & 3, fr = lane & 15, fq = lane >> 4;
    const int K = g.K, nt = K / BK;
    unsigned voffA[2], voffB[2];
#pragma unroll
    for (int i = 0; i < 2; ++i) { int R, C; stage_rc(tid * 16 + i * 8192, R, C); const int Rb = Epi::PERM ? ((R & ~31) + perm32(R & 31)) : R;
        voffA[i] = (unsigned)(R * K + C) * 2u; voffB[i] = (unsigned)(Rb * K + C) * 2u; }
    const size_t kstep = (size_t)(BK * 2);
    const size_t hstep = (size_t)HALF * K * 2;
    const size_t tstep = 2 * hstep;
    const unsigned ldsw = (unsigned)wid * 1024u;
    const int aoff = lds_byte(wr * 64 + fr, fq * 8), boff = lds_byte(wc * 32 + fr, fq * 8);
#define PG8_SA(b, h) (((b) * 2 + (h)) * HTB)
#define PG8_SB(b, h) ((4 + (b) * 2 + (h)) * HTB)
#define PG8_STAGE(bufoff, gbase, voff) do { _Pragma("unroll") for (int _i = 0; _i < 2; ++_i) \
        __builtin_amdgcn_global_load_lds((const unsigned*)((const char*)(gbase) + (voff)[_i]), (PG8_LAS unsigned*)(lds + (bufoff) + ldsw + _i * 8192), 16, 0, 0); } while (0)
#define PG8_LDA(dst, b, h) do { _Pragma("unroll") for (int m = 0; m < 4; ++m) _Pragma("unroll") for (int k = 0; k < 2; ++k) dst[m][k] = *(const PG8_LAS bf16x8*)(lds + PG8_SA(b, h) + aoff + m * 2048 + k * 1024); } while (0)
#define PG8_LDB(dst, b, h) do { _Pragma("unroll") for (int n = 0; n < 2; ++n) _Pragma("unroll") for (int k = 0; k < 2; ++k) dst[n][k] = *(const PG8_LAS bf16x8*)(lds + PG8_SB(b, h) + boff + n * 2048 + k * 1024); } while (0)
#define PG8_MMA(ai, bj, At, Bt) do { __builtin_amdgcn_s_setprio(1); _Pragma("unroll") for (int m = 0; m < 4; ++m) _Pragma("unroll") for (int n = 0; n < 2; ++n) _Pragma("unroll") for (int k = 0; k < 2; ++k) \
        acc[ai][bj][m][n] = __builtin_amdgcn_mfma_f32_16x16x32_bf16(Bt[n][k], At[m][k], acc[ai][bj][m][n], 0, 0, 0); __builtin_amdgcn_s_setprio(0); } while (0)
#define PG8_WAIT_V(n) asm volatile("s_waitcnt vmcnt(" #n ")" ::: "memory")
#define PG8_WAIT_L(n) asm volatile("s_waitcnt lgkmcnt(" #n ")" ::: "memory")
#define PG8_BAR __builtin_amdgcn_s_barrier()
#define PG8_SCHED __builtin_amdgcn_sched_barrier(0)
    Unit cur, nxt; int ui = 0;
    if (!S.next(0, cur)) return;
    f32x4 acc[2][2][4][2];
#pragma unroll
    for (int a = 0; a < 2; ++a)
#pragma unroll
        for (int b = 0; b < 2; ++b)
#pragma unroll
            for (int m = 0; m < 4; ++m)
#pragma unroll
                for (int n = 0; n < 2; ++n) acc[a][b][m][n] = (f32x4){0.f, 0.f, 0.f, 0.f};
    bf16x8 At[4][2], B0[2][2], B1[2][2];
    const char* cA = (const char*)g.A + (size_t)cur.pm * tstep; const char* cB = (const char*)g.Bt + (size_t)cur.pn * tstep;
    S.a_ready(cur);
    PG8_STAGE(PG8_SB(0, 0), cB, voffB); PG8_STAGE(PG8_SA(0, 0), cA, voffA); PG8_STAGE(PG8_SB(0, 1), cB + hstep, voffB); PG8_STAGE(PG8_SA(0, 1), cA + hstep, voffA);
    if (wr == 1) PG8_BAR;
    PG8_WAIT_V(4); PG8_BAR;
    PG8_STAGE(PG8_SB(1, 0), cB + kstep, voffB); PG8_STAGE(PG8_SA(1, 0), cA + kstep, voffA); PG8_STAGE(PG8_SB(1, 1), cB + hstep + kstep, voffB);
    PG8_WAIT_V(6); PG8_BAR;
    for (;;) {
        const bool has_next = S.next(ui + 1, nxt);
        const char* nA = has_next ? (const char*)g.A + (size_t)nxt.pm * tstep : cA; const char* nB = has_next ? (const char*)g.Bt + (size_t)nxt.pn * tstep : cB;
        for (int t = 0; t < nt; t += 2) {
            const bool last = (t == nt - 2);
            const char* a1 = cA + (size_t)(t + 1) * kstep;
            const char* a2 = last ? nA : cA + (size_t)(t + 2) * kstep; const char* b2 = last ? nB : cB + (size_t)(t + 2) * kstep;
            const char* a3 = a2 + kstep; const char* b3 = b2 + kstep;
            if (last && has_next) S.a_ready(nxt);
            PG8_LDB(B0, 0, 0); PG8_SCHED; PG8_LDA(At, 0, 0); PG8_STAGE(PG8_SA(1, 1), a1 + hstep, voffA);
            PG8_WAIT_L(8); PG8_BAR; PG8_WAIT_L(0); PG8_MMA(0, 0, At, B0); PG8_BAR; PG8_SCHED;
            PG8_LDB(B1, 0, 1); PG8_STAGE(PG8_SB(0, 0), b2, voffB);
            PG8_BAR; PG8_WAIT_L(0); PG8_MMA(0, 1, At, B1); PG8_BAR;
            PG8_LDA(At, 0, 1); PG8_STAGE(PG8_SA(0, 0), a2, voffA);
            PG8_BAR; PG8_WAIT_L(0); PG8_MMA(1, 0, At, B0); PG8_BAR; PG8_SCHED;
            PG8_STAGE(PG8_SB(0, 1), b2 + hstep, voffB);
            PG8_WAIT_V(6); PG8_BAR; PG8_MMA(1, 1, At, B1); PG8_BAR;
            PG8_LDB(B0, 1, 0); PG8_SCHED; PG8_LDA(At, 1, 0); PG8_STAGE(PG8_SA(0, 1), a2 + hstep, voffA);
            PG8_WAIT_L(8); PG8_BAR; PG8_WAIT_L(0); PG8_MMA(0, 0, At, B0); PG8_BAR; PG8_SCHED;
            PG8_LDB(B1, 1, 1); PG8_STAGE(PG8_SB(1, 0), b3, voffB);
            PG8_BAR; PG8_WAIT_L(0); PG8_MMA(0, 1, At, B1); PG8_BAR;
            PG8_LDA(At, 1, 1); PG8_STAGE(PG8_SA(1, 0), a3, voffA);
            PG8_BAR; PG8_WAIT_L(0); PG8_MMA(1, 0, At, B0); PG8_BAR; PG8_SCHED;
            PG8_STAGE(PG8_SB(1, 1), b3 + hstep, voffB);
            PG8_WAIT_V(6); PG8_BAR; PG8_MMA(1, 1, At, B1); PG8_BAR;
        }
        if constexpr (!Epi::AFTER_DRAIN) { E(acc, cur, wr, wc, fr, fq); S.done(cur); }
        if (!has_next) break;
#pragma unroll
        for (int a = 0; a < 2; ++a)
#pragma unroll
            for (int b = 0; b < 2; ++b)
#pragma unroll
                for (int m = 0; m < 4; ++m)
#pragma unroll
                    for (int n = 0; n < 2; ++n) acc[a][b][m][n] = (f32x4){0.f, 0.f, 0.f, 0.f};
        cur = nxt; cA = nA; cB = nB; ++ui;
    }
    PG8_WAIT_V(0);
    if (wr == 0) PG8_BAR;
    PG8_BAR;
    if constexpr (Epi::AFTER_DRAIN) { E.fused(acc, cur, wr, wc, fr, fq, lds, wid, lane); S.done(cur); }
#undef PG8_SA
#undef PG8_SB
#undef PG8_STAGE
#undef PG8_LDA
#undef PG8_LDB
#undef PG8_MMA
#undef PG8_WAIT_V
#undef PG8_WAIT_L
#undef PG8_BAR
#undef PG8_SCHED
}
}


using pg8::Unit;
typedef f32x4 AccT[2][2][4][2];

struct EpiProj {
    static constexpr bool PERM = true, AFTER_DRAIN = false;
    bf16_t* P; float* out;
    __device__ __forceinline__ void operator()(const AccT& acc, const Unit& u, int wr, int wc, int fr, int fq) const {
        const int row0 = u.pm * 256 + wr * 64 + fr, col0 = u.pn * 256 + wc * 32 + 8 * fq;
#pragma unroll
        for (int ai = 0; ai < 2; ++ai)
#pragma unroll
            for (int m = 0; m < 4; ++m) {
                const int r = row0 + ai * 128 + m * 16;
                const bool last = r < T_PR ? ((r & (SEQ_P - 1)) == SEQ_P - 1) : ((r & (SEQ_S - 1)) == SEQ_S - 1);
#pragma unroll
                for (int bj = 0; bj < 2; ++bj) {
                    const int c = col0 + bj * 128; const f32x4 v0 = acc[ai][bj][m][0], v1 = acc[ai][bj][m][1];
                    u32x4 w; w.x = pk2(v0[0], v0[1]); w.y = pk2(v0[2], v0[3]); w.z = pk2(v1[0], v1[1]); w.w = pk2(v1[2], v1[3]);
                    *(u32x4*)(P + (size_t)r * NINP + c) = w;
                    if (last && c < NSH) {
                        float* o = r < T_PR ? out + O_SHP + (size_t)(r >> 12) * NSH + c : out + O_SHS + (size_t)((r - T_PR) >> 6) * NSH + c;
                        *(f32x4*)o = v0; *(f32x4*)(o + 4) = v1;
                    }
                }
            }
    }
};
struct EpiLora {
    static constexpr bool PERM = true, AFTER_DRAIN = false;
    float* DEC; bf16_t* A; const float* w0; const float* a0;
    __device__ __forceinline__ void operator()(const AccT& acc, const Unit& u, int wr, int wc, int fr, int fq) const {
        const int row0 = u.pm * 256 + wr * 64 + fr, colt = (u.pn & 3) * 256 + wc * 32 + 8 * fq, kind = u.pn >> 2;
        const float* bp = (kind == 0 ? w0 : a0) + colt;
        const float bsc = kind < 2 ? 1.f : 0.f;
#pragma unroll
        for (int bj = 0; bj < 2; ++bj) {
            const f32x4 b0 = *(const f32x4*)(bp + bj * 128) * bsc, b1 = *(const f32x4*)(bp + bj * 128 + 4) * bsc;
#pragma unroll
            for (int ai = 0; ai < 2; ++ai)
#pragma unroll
                for (int m = 0; m < 4; ++m) {
                    const int r = row0 + ai * 128 + m * 16;
                    const int c = colt + bj * 128; f32x4 v0 = acc[ai][bj][m][0] + b0, v1 = acc[ai][bj][m][1] + b1;
                    if (kind == 0) {
#pragma unroll
                        for (int e = 0; e < 4; ++e) {
                            v0[e] = __expf(-0.6065306597126334f * sigmoidf_(v0[e])); v1[e] = __expf(-0.6065306597126334f * sigmoidf_(v1[e]));
                        }
                        *(f32x4*)(DEC + (size_t)r * DR + c) = v0; *(f32x4*)(DEC + (size_t)r * DR + c + 4) = v1;
                    } else {
                        if (kind == 1) {
#pragma unroll
                            for (int e = 0; e < 4; ++e) { v0[e] = sigmoidf_(v0[e]); v1[e] = sigmoidf_(v1[e]); }
                        }
                        u32x4 w; w.x = pk2(v0[0], v0[1]); w.y = pk2(v0[2], v0[3]); w.z = pk2(v1[0], v1[1]); w.w = pk2(v1[2], v1[3]);
                        *(u32x4*)(A + (size_t)(kind - 1) * ((size_t)T_ALL * DR) + (size_t)r * DR + c) = w;
                    }
                    asm volatile("" ::: "memory");
                }
        }
    }
};
struct EpiGlu {
    static constexpr bool PERM = true, AFTER_DRAIN = false;
    const bf16_t* Z; bf16_t* O; const float* bias;
    __device__ __forceinline__ void operator()(const AccT& acc, const Unit& u, int wr, int wc, int fr, int fq) const {
        const int row0 = u.pm * 256 + wr * 64 + fr, col0 = u.pn * 256 + wc * 32 + 8 * fq;
        f32x4 bv[2][2];
#pragma unroll
        for (int bj = 0; bj < 2; ++bj) { bv[bj][0] = *(const f32x4*)(bias + col0 + bj * 128); bv[bj][1] = *(const f32x4*)(bias + col0 + bj * 128 + 4); }
#pragma unroll
        for (int ai = 0; ai < 2; ++ai)
#pragma unroll
            for (int m = 0; m < 4; ++m) {
                const int r = row0 + ai * 128 + m * 16;
#pragma unroll
                for (int bj = 0; bj < 2; ++bj) {
                    const int c = col0 + bj * 128; const f32x4 v0 = acc[ai][bj][m][0] + bv[bj][0], v1 = acc[ai][bj][m][1] + bv[bj][1];
                    const u32x4 z = *(const u32x4*)(Z + (size_t)r * DR + c);
                    u32x4 w;
                    w.x = pk2(lo16(z.x) * sigmoidf_(v0[0]), hi16(z.x) * sigmoidf_(v0[1]));
                    w.y = pk2(lo16(z.y) * sigmoidf_(v0[2]), hi16(z.y) * sigmoidf_(v0[3]));
                    w.z = pk2(lo16(z.z) * sigmoidf_(v1[0]), hi16(z.z) * sigmoidf_(v1[1]));
                    w.w = pk2(lo16(z.w) * sigmoidf_(v1[2]), hi16(z.w) * sigmoidf_(v1[3]));
                    *(u32x4*)(O + (size_t)r * D + DR + c) = w;
                }
                asm volatile("" ::: "memory");
            }
    }
};
struct EpiRes {
    static constexpr bool PERM = false, AFTER_DRAIN = false;
    const bf16_t* X; float* Y;
    __device__ __forceinline__ void operator()(const AccT& acc, const Unit& u, int wr, int wc, int fr, int fq) const {
        const int row0 = u.pm * 256 + wr * 64 + fr, col0 = u.pn * 256 + wc * 32 + 4 * fq;
#pragma unroll
        for (int ai = 0; ai < 2; ++ai)
#pragma unroll
            for (int m = 0; m < 4; ++m) {
                const size_t off = (size_t)(row0 + ai * 128 + m * 16) * D + col0;
#pragma unroll
                for (int bj = 0; bj < 2; ++bj)
#pragma unroll
                    for (int n = 0; n < 2; ++n) {
                        const u32x2 x = *(const u32x2*)(X + off + bj * 128 + n * 16);
                        f32x4 o = acc[ai][bj][m][n];
                        o[0] += ALPHA * lo16(x.x); o[1] += ALPHA * hi16(x.x); o[2] += ALPHA * lo16(x.y); o[3] += ALPHA * hi16(x.y);
                        *(f32x4*)(Y + off + bj * 128 + n * 16) = o;
                    }
                asm volatile("" ::: "memory");
            }
    }
};
struct EpiFfn1 {
    static constexpr bool PERM = false, AFTER_DRAIN = false;
    bf16_t* H;
    __device__ __forceinline__ void operator()(const AccT& acc, const Unit& u, int wr, int wc, int fr, int fq) const {
        const int row0 = u.pm * 256 + wr * 64 + fr, col0 = u.pn * 128 + wc * 16 + 4 * fq;
#pragma unroll
        for (int ai = 0; ai < 2; ++ai)
#pragma unroll
            for (int m = 0; m < 4; ++m) {
                bf16_t* rowp = H + (size_t)(row0 + ai * 128 + m * 16) * DFF + col0;
#pragma unroll
                for (int bj = 0; bj < 2; ++bj) {
                    const f32x4 a1 = acc[ai][bj][m][0], a3 = acc[ai][bj][m][1];
                    float h[4];
#pragma unroll
                    for (int e = 0; e < 4; ++e) h[e] = a1[e] * sigmoidf_(a1[e]) * a3[e];
                    u32x2 w; w.x = pk2(h[0], h[1]); w.y = pk2(h[2], h[3]);
                    *(u32x2*)(rowp + bj * 64) = w;
                }
            }
    }
};

__device__ __forceinline__ bool is_first(int t) { return t < T_PR ? ((t & (SEQ_P - 1)) == 0) : ((t & (SEQ_S - 1)) == 0); }

template <int MODE>
__device__ __forceinline__ void transpose_item(const float* __restrict__ W, int K, int N, bf16_t* __restrict__ WT, LAS float* scr, int item, int lane) {
    const int nblk = N / 32, kb = item / nblk, nb = item % nblk, k0 = 64 * kb, n0 = 32 * nb;
#pragma unroll 8
    for (int i = 0; i < 32; ++i) { const int kk = 2 * i + (lane >> 5); scr[kk * 33 + (lane & 31)] = W[(size_t)(k0 + kk) * N + n0 + (lane & 31)]; }
    asm volatile("s_waitcnt lgkmcnt(0)" ::: "memory");
    const int c = lane & 7;
#pragma unroll
    for (int j = 0; j < 4; ++j) {
        const int n = (lane >> 3) + 8 * j; const LAS float* s = scr + (8 * c) * 33 + n;
        u32x4 o; o.x = pk2(s[0 * 33], s[1 * 33]); o.y = pk2(s[2 * 33], s[3 * 33]); o.z = pk2(s[4 * 33], s[5 * 33]); o.w = pk2(s[6 * 33], s[7 * 33]);
        const int drow = MODE == 0 ? (n0 + n) : (2 * n0 + 32 * (n >> 4) + (n & 15) + (MODE == 2 ? 16 : 0));
        *(u32x4*)(WT + (size_t)drow * K + k0 + 8 * c) = o;
    }
    asm volatile("s_waitcnt lgkmcnt(0)" ::: "memory");
}

__device__ __forceinline__ void ln_row(const float* __restrict__ xrow, const float* __restrict__ g, const float* __restrict__ b, bf16_t* orow, float* frow, int lane) {
    f32x4 v[8]; float s = 0.f;
#pragma unroll
    for (int j = 0; j < 8; ++j) { v[j] = *(const f32x4*)(xrow + 256 * j + 4 * lane); s += (v[j][0] + v[j][1]) + (v[j][2] + v[j][3]); }
    const float mean = wave_sum(s) * (1.f / D); float s2 = 0.f;
#pragma unroll
    for (int j = 0; j < 8; ++j) { v[j] = v[j] - mean; s2 += (v[j][0] * v[j][0] + v[j][1] * v[j][1]) + (v[j][2] * v[j][2] + v[j][3] * v[j][3]); }
    const float rstd = 1.f / sqrtf(wave_sum(s2) * (1.f / D) + LN_EPS);
#pragma unroll
    for (int j = 0; j < 8; ++j) {
        const f32x4 gg = *(const f32x4*)(g + 256 * j + 4 * lane), bb = *(const f32x4*)(b + 256 * j + 4 * lane);
        const f32x4 o = v[j] * rstd * gg + bb;
        if (orow) { u32x2 w; w.x = pk2(o[0], o[1]); w.y = pk2(o[2], o[3]); *(u32x2*)(orow + 256 * j + 4 * lane) = w; }
        if (frow) *(f32x4*)(frow + 256 * j + 4 * lane) = o;
    }
}

__device__ void phase_prep(const Params& p, LAS unsigned char* lds) {
    const int tid = threadIdx.x, lane = tid & 63, wave = tid >> 6;
    const int gw = blockIdx.x * 8 + wave, NGW = gridDim.x * 8;
    const int gt = blockIdx.x * 512 + tid, NGT = gridDim.x * 512;
    unsigned char* ws = p.ws;
    LAS float* scr = (LAS float*)(lds + wave * 8448);
    bf16_t* WIN = (bf16_t*)(ws + WS_WIN); bf16_t* WGLU = (bf16_t*)(ws + WS_WGLU); bf16_t* WOUT = (bf16_t*)(ws + WS_WOUT);
    bf16_t* W13 = (bf16_t*)(ws + WS_W13); bf16_t* W2 = (bf16_t*)(ws + WS_W2); bf16_t* WLORA = (bf16_t*)(ws + WS_WLORA);
    constexpr int I_IN = 32 * 137, I_GLU = 16 * 32, I_OUT = 32 * 64, I_W1 = 32 * 176, I_W2 = 88 * 64;
    constexpr int NITEMS = I_IN + I_GLU + I_OUT + 2 * I_W1 + I_W2;
    for (int it = gw; it < NITEMS; it += NGW) {
        int r = it;
        if (r < I_IN) { transpose_item<0>(p.in[8], D, 4384, WIN, scr, r, lane); continue; } r -= I_IN;
        if (r < I_GLU) { transpose_item<0>(p.in[28], DR, DR, WGLU, scr, r, lane); continue; } r -= I_GLU;
        if (r < I_OUT) { transpose_item<0>(p.in[30], D, D, WOUT, scr, r, lane); continue; } r -= I_OUT;
        if (r < I_W1) { transpose_item<1>(p.in[33], D, DFF, W13, scr, r, lane); continue; } r -= I_W1;
        if (r < I_W1) { transpose_item<2>(p.in[34], D, DFF, W13, scr, r, lane); continue; } r -= I_W1;
        transpose_item<0>(p.in[35], DFF, D, W2, scr, r, lane);
    }
    for (int i = gt; i < (NINP - 4384) * D / 8; i += NGT) *(u32x4*)(WIN + (size_t)4384 * D + (size_t)i * 8) = (u32x4){0u, 0u, 0u, 0u};
    for (int i = gt; i < LORA_N * LORA_K; i += NGT) {
        const int n = i / LORA_K, k = i - n * LORA_K; float v = 0.f;
        if (n < 1024) { if (k < 64) v = p.in[11][(size_t)k * 1024 + n]; }
        else if (n < 2048) { if (k >= 64 && k < 128) v = p.in[13][(size_t)(k - 64) * 1024 + (n - 1024)]; }
        else { if (k >= 128 && k < 288) v = p.in[14][(size_t)(k - 128) * 1024 + (n - 2048)]; }
        WLORA[i] = (bf16_t)f2bf(v);
    }
    bf16_t* XN = (bf16_t*)(ws + WS_XN);
    for (int t = gw; t < T_ALL; t += NGW) {
        const float* xr = t < T_PR ? p.in[0] + (size_t)t * D : p.in[1] + (size_t)(t - T_PR) * D;
        ln_row(xr, p.in[6], p.in[7], XN + (size_t)t * D, nullptr, lane);
    }
    if (gt < 4096) {
        const int g = gt >> 6, pp = gt & 63;
        const double dt = exp((double)p.in[22][g]);
        const double ar = (double)p.in[20][gt], ai = (double)p.in[21][gt];
        const double er = exp(ar * dt); double th = ai * dt;
        const double TWO_PI = 6.283185307179586476925286766559;
        th -= TWO_PI * rint(th / TWO_PI);
        double sn = th, cs = 1.0, term_s = th, term_c = 1.0; const double t2 = th * th;
        for (int k = 1; k < 16; ++k) { term_c *= -t2 / (double)((2 * k - 1) * (2 * k)); cs += term_c; term_s *= -t2 / (double)((2 * k) * (2 * k + 1)); sn += term_s; }
        const double lr = er * cs, li = er * sn;
        float* LAM = (float*)(ws + WS_S5P + S5_LAM);
        LAM[2 * gt] = (float)lr; LAM[2 * gt + 1] = (float)li;
        const double den = ar * ar + ai * ai, xr_ = lr - 1.0, xi_ = li;
        const double qr = (xr_ * ar + xi_ * ai) / den, qi = (xi_ * ar - xr_ * ai) / den;
        bf16_t* BB = (bf16_t*)(ws + WS_S5P + S5_BB) + (size_t)g * 128 * 16;
        bf16_t* CM = (bf16_t*)(ws + WS_S5P + S5_CM) + (size_t)g * 16 * 128;
        for (int k = 0; k < 16; ++k) {
            const double br = (double)p.in[23][(size_t)gt * 16 + k], bi = (double)p.in[24][(size_t)gt * 16 + k];
            BB[(2 * pp) * 16 + k] = (bf16_t)f2bf((float)(qr * br - qi * bi));
            BB[(2 * pp + 1) * 16 + k] = (bf16_t)f2bf((float)(qr * bi + qi * br));
            CM[k * 128 + 2 * pp] = (bf16_t)f2bf(p.in[25][((size_t)g * 16 + k) * 64 + pp]);
            CM[k * 128 + 2 * pp + 1] = (bf16_t)f2bf(-p.in[26][((size_t)g * 16 + k) * 64 + pp]);
        }
    }
}

__device__ void phase_la(const Params& p) {
    const int gt = blockIdx.x * 512 + threadIdx.x, NGT = gridDim.x * 512;
    const bf16_t* PROJ = (const bf16_t*)(p.ws + WS_PROJ); bf16_t* LA = (bf16_t*)(p.ws + WS_LA);
    const float* mu = p.in[9]; const float* cshift = p.in[2];
    for (int i = gt; i < T_ALL * 48; i += NGT) {
        const int t = i / 48, c8 = (i - t * 48) * 8;
        u32x4 o = (u32x4){0u, 0u, 0u, 0u};
        if (c8 < 288) {
            const int col = 3072 + c8;
            const u32x4 cur = *(const u32x4*)(PROJ + (size_t)t * NINP + col);
            float pv[8], cv[8];
            cv[0] = lo16(cur.x); cv[1] = hi16(cur.x); cv[2] = lo16(cur.y); cv[3] = hi16(cur.y); cv[4] = lo16(cur.z); cv[5] = hi16(cur.z); cv[6] = lo16(cur.w); cv[7] = hi16(cur.w);
            if (!is_first(t)) {
                const u32x4 pr = *(const u32x4*)(PROJ + (size_t)(t - 1) * NINP + col);
                pv[0] = lo16(pr.x); pv[1] = hi16(pr.x); pv[2] = lo16(pr.y); pv[3] = hi16(pr.y); pv[4] = lo16(pr.z); pv[5] = hi16(pr.z); pv[6] = lo16(pr.w); pv[7] = hi16(pr.w);
            } else if (t >= T_PR) {
                const float* cs = cshift + (size_t)((t - T_PR) >> 6) * NSH + col;
#pragma unroll
                for (int e = 0; e < 8; ++e) pv[e] = cs[e];
            } else {
#pragma unroll
                for (int e = 0; e < 8; ++e) pv[e] = 0.f;
            }
            float r[8];
#pragma unroll
            for (int e = 0; e < 8; ++e) {
                const float ps = cv[e] + (pv[e] - cv[e]) * mu[col + e];
                r[e] = c8 < 64 ? tanhf_(ps) : (c8 < 128 ? ps : sigmoidf_(ps));
            }
            o.x = pk2(r[0], r[1]); o.y = pk2(r[2], r[3]); o.z = pk2(r[4], r[5]); o.w = pk2(r[6], r[7]);
        }
        *(u32x4*)(LA + (size_t)t * LORA_K + c8) = o;
    }
}

#ifndef PROBE_REP
#define PROBE_REP 0
#endif

constexpr int WK_BUF = 11264, WK_YB = 2 * WK_BUF;
struct WkvRaw { unsigned r[9], k[9], v[9], a[8]; float dec[8]; float p_r, p_k, p_v; };
struct WkvOps { f32x4 w0, w1, kk0, kk1, nb0, nb1, k0, k1, r0, r1; float v; };

__device__ __forceinline__ float allreduce8(float x) { x += dppf<0xB1>(x); x += dppf<0x4E>(x); x += dppf<0x141>(x); return x; }
__device__ __forceinline__ float xrow_sum(float x) {
    auto s = __builtin_amdgcn_permlane16_swap(__float_as_uint(x), __float_as_uint(x), false, false);
    x = __uint_as_float(s[0]) + __uint_as_float(s[1]);
    auto t = __builtin_amdgcn_permlane32_swap(__float_as_uint(x), __float_as_uint(x), false, false);
    return __uint_as_float(t[0]) + __uint_as_float(t[1]);
}
__device__ __forceinline__ float wave_sum_dpp(float x) { x = allreduce8(x); x += dppf<0x140>(x); return xrow_sum(x); }

__device__ __forceinline__ void wkv_task(const Params& p, LAS float* L, int tok0, int len, int h, int half, const float* s0, float* sout, const float* shift0) {
    const int tid = threadIdx.x, lane = tid & 63, wave = __builtin_amdgcn_readfirstlane(tid >> 6);
    const bf16_t* PROJ = (const bf16_t*)(p.ws + WS_PROJ);
    const float* DEC = (const float*)((const unsigned char*)p.out + DO_DEC);
    const bf16_t* AA = (const bf16_t*)((const unsigned char*)p.out + DO_A);
    bf16_t* YW = (bf16_t*)(p.ws + WS_YW);
    const int nch = len / 32;
    if (wave < 4) {
        const int irow = wave * 8 + (lane >> 3), j8 = lane & 7, i = half * 32 + irow;
        f32x4 Sa = (f32x4){0.f, 0.f, 0.f, 0.f}, Sb = Sa;
        if (s0) { Sa = *(const f32x4*)(s0 + (size_t)i * 64 + 8 * j8); Sb = *(const f32x4*)(s0 + (size_t)i * 64 + 8 * j8 + 4); }
        __syncthreads();
        for (int c = 0; c < nch; ++c) {
            const LAS float* B = L + (c & 1) * WK_BUF + 8 * j8; LAS float* YB = L + WK_YB + (c & 1) * 1024;
            const LAS float* Bv = L + (c & 1) * WK_BUF + 10240 + irow;
            WkvOps cur, nxt;
#define WK_LOAD(o, t) do { const LAS float* b_ = B + (t) * 64; \
            o.w0 = *(const LAS f32x4*)(b_); o.w1 = *(const LAS f32x4*)(b_ + 4); o.kk0 = *(const LAS f32x4*)(b_ + 2048); o.kk1 = *(const LAS f32x4*)(b_ + 2052); \
            o.nb0 = *(const LAS f32x4*)(b_ + 4096); o.nb1 = *(const LAS f32x4*)(b_ + 4100); o.k0 = *(const LAS f32x4*)(b_ + 6144); o.k1 = *(const LAS f32x4*)(b_ + 6148); \
            o.r0 = *(const LAS f32x4*)(b_ + 8192); o.r1 = *(const LAS f32x4*)(b_ + 8196); o.v = Bv[(t) * 32]; } while (0)
            WK_LOAD(cur, 0);
            float ykeep = 0.f;
#pragma unroll
            for (int t = 0; t < 32; ++t) {
                if (t + 1 < 32) WK_LOAD(nxt, t + 1);
                const f32x4 pa = Sa * cur.kk0 + Sb * cur.kk1;
                float sa = (pa[0] + pa[1]) + (pa[2] + pa[3]);
                sa = allreduce8(sa);
                Sa = Sa * cur.w0 + (cur.v * cur.k0 + sa * cur.nb0);
                Sb = Sb * cur.w1 + (cur.v * cur.k1 + sa * cur.nb1);
                const f32x4 py = Sa * cur.r0 + Sb * cur.r1;
                float y = (py[0] + py[1]) + (py[2] + py[3]);
                y = allreduce8(y);
                ykeep = (j8 == (t & 7)) ? y : ykeep;
                if ((t & 7) == 7) YB[((t >> 3) * 8 + j8) * 32 + irow] = ykeep;
                if (t + 1 < 32) cur = nxt;
            }
#undef WK_LOAD
            __syncthreads();
        }
        *(f32x4*)(sout + (size_t)i * 64 + 8 * j8) = Sa; *(f32x4*)(sout + (size_t)i * 64 + 8 * j8 + 4) = Sb;
    } else {
        const int sw = wave - 4;
        const int cr = h * 64 + lane, ck = 1024 + cr, cv = 2048 + cr;
        const float mu_r = p.in[9][cr], mu_k = p.in[9][ck], mu_v = p.in[9][cv], kkc = p.in[15][cr], kac = p.in[16][cr];
        WkvRaw raw;
        auto stage_load = [&](int c) {
            const int tq = tok0 + c * 32 + sw * 8;
#pragma unroll
            for (int q = 0; q < 9; ++q) {
                const int t = tq + q - 1;
                if (q == 0 && t < tok0) {
                    raw.r[0] = raw.k[0] = raw.v[0] = 0u;
                    raw.p_r = shift0 ? shift0[cr] : 0.f; raw.p_k = shift0 ? shift0[ck] : 0.f; raw.p_v = shift0 ? shift0[cv] : 0.f;
                } else {
                    const bf16_t* row = PROJ + (size_t)t * NINP;
                    raw.r[q] = row[cr]; raw.k[q] = row[ck]; raw.v[q] = row[cv];
                    if (q == 0) { raw.p_r = raw.p_k = raw.p_v = 0.f; }
                }
            }
#pragma unroll
            for (int q = 0; q < 8; ++q) { raw.dec[q] = DEC[(size_t)(tq + q) * DR + cr]; raw.a[q] = AA[(size_t)(tq + q) * DR + cr]; }
        };
        auto stage_write = [&](int c, LAS float* B) {
            const bool firstrow = (c == 0 && sw == 0);
#pragma unroll
            for (int q = 0; q < 8; ++q) {
                const int tt = sw * 8 + q;
                const float c_r = bf2f(raw.r[q + 1]), c_k = bf2f(raw.k[q + 1]), c_v = bf2f(raw.v[q + 1]);
                float pr = bf2f(raw.r[q]), pk = bf2f(raw.k[q]), pv = bf2f(raw.v[q]);
                if (q == 0 && firstrow) { pr = raw.p_r; pk = raw.p_k; pv = raw.p_v; }
                const float r = c_r + (pr - c_r) * mu_r, kx = c_k + (pk - c_k) * mu_k, v = c_v + (pv - c_v) * mu_v;
                const float a = bf2f(raw.a[q]);
                const float kkv = kx * kkc;
                const float ss = wave_sum_dpp(kkv * kkv);
                const float kk = kkv * __builtin_amdgcn_rsqf(fmaxf(ss, 1e-24f));
                const float kp = kx * (1.f + (a - 1.f) * kac);
                B[tt * 64 + lane] = raw.dec[q]; B[2048 + tt * 64 + lane] = kk; B[4096 + tt * 64 + lane] = -kk * a; B[6144 + tt * 64 + lane] = kp; B[8192 + tt * 64 + lane] = r;
                if ((lane >> 5) == half) B[10240 + tt * 32 + (lane & 31)] = v;
            }
        };
        stage_load(0); stage_write(0, L);
        if (nch > 1) stage_load(1);
        __syncthreads();
        for (int c = 0; c < nch; ++c) {
            if (c > 0) {
                const LAS float* YB = L + WK_YB + ((c - 1) & 1) * 1024;
                const int idx = (tid - 256), t = idx >> 3, i4 = (idx & 7) * 4;
                const f32x4 yy = *(const LAS f32x4*)(YB + t * 32 + i4);
                u32x2 w; w.x = pk2(yy[0], yy[1]); w.y = pk2(yy[2], yy[3]);
                *(u32x2*)(YW + (size_t)(tok0 + (c - 1) * 32 + t) * DR + h * 64 + half * 32 + i4) = w;
            }
            if (c + 1 < nch) { stage_write(c + 1, L + ((c + 1) & 1) * WK_BUF); if (c + 2 < nch) stage_load(c + 2); }
            __syncthreads();
        }
        {
            const LAS float* YB = L + WK_YB + ((nch - 1) & 1) * 1024;
            const int idx = (tid - 256), t = idx >> 3, i4 = (idx & 7) * 4;
            const f32x4 yy = *(const LAS f32x4*)(YB + t * 32 + i4);
            u32x2 w; w.x = pk2(yy[0], yy[1]); w.y = pk2(yy[2], yy[3]);
            *(u32x2*)(YW + (size_t)(tok0 + (nch - 1) * 32 + t) * DR + h * 64 + half * 32 + i4) = w;
        }
    }
    __syncthreads();
}

__device__ __forceinline__ float gelu_tanh(float y) { const float u = 0.7978845608028654f * (y + 0.044715f * y * y * y); return 0.5f * y * (1.f + tanhf_(u)); }

__device__ __forceinline__ void s5_task(const Params& p, LAS unsigned char* wl, int tok0, int len, int g, const float* h0r, const float* h0i, float* outr, float* outi) {
    const int lane = threadIdx.x & 63, fr = lane & 15, fq = lane >> 4;
    LAS float* bufF = (LAS float*)wl;
    LAS unsigned* hb = (LAS unsigned*)(wl + 8448);
    const bf16_t* PROJ = (const bf16_t*)(p.ws + WS_PROJ);
    bf16_t* Z = (bf16_t*)(p.ws + WS_Z);
    const bf16_t* BB = (const bf16_t*)(p.ws + WS_S5P + S5_BB) + (size_t)g * 128 * 16;
    const bf16_t* CM = (const bf16_t*)(p.ws + WS_S5P + S5_CM) + (size_t)g * 16 * 128;
    const float* LAM = (const float*)(p.ws + WS_S5P + S5_LAM) + (size_t)(g * 64 + lane) * 2;
    const bf16x8 zero8 = (bf16x8){0, 0, 0, 0, 0, 0, 0, 0};
    bf16x8 bb[8], cm[4];
#pragma unroll
    for (int nb = 0; nb < 8; ++nb) bb[nb] = fq < 2 ? *(const bf16x8*)(BB + (nb * 16 + fr) * 16 + fq * 8) : zero8;
#pragma unroll
    for (int kk = 0; kk < 4; ++kk) cm[kk] = *(const bf16x8*)(CM + fr * 128 + kk * 32 + fq * 8);
    const float lr = LAM[0], li = LAM[1];
    const f32x4 dv = *(const f32x4*)(p.in[27] + g * 16 + fq * 4);
    float hr = h0r ? h0r[lane] : 0.f, hi = h0i ? h0i[lane] : 0.f;
    const int ntile = len / 16;
    const size_t ucol = NSH + g * 16;
    bf16x8 uf = fq < 2 ? *(const bf16x8*)(PROJ + (size_t)(tok0 + fr) * NINP + ucol + fq * 8) : zero8;
    u32x2 ud = *(const u32x2*)(PROJ + (size_t)(tok0 + fr) * NINP + ucol + fq * 4);
    for (int tile = 0; tile < ntile; ++tile) {
        const int t0 = tok0 + tile * 16;
        const bf16x8 ufc = uf; const u32x2 udc = ud;
        if (tile + 1 < ntile) {
            uf = fq < 2 ? *(const bf16x8*)(PROJ + (size_t)(t0 + 16 + fr) * NINP + ucol + fq * 8) : zero8;
            ud = *(const u32x2*)(PROJ + (size_t)(t0 + 16 + fr) * NINP + ucol + fq * 4);
        }
#pragma unroll
        for (int nb = 0; nb < 8; ++nb) {
            const f32x4 a = __builtin_amdgcn_mfma_f32_16x16x32_bf16(bb[nb], ufc, (f32x4){0.f, 0.f, 0.f, 0.f}, 0, 0, 0);
            *(LAS f32x4*)(bufF + fr * 132 + nb * 16 + fq * 4) = a;
        }
        asm volatile("s_waitcnt lgkmcnt(0)" ::: "memory");
#pragma unroll
        for (int t = 0; t < 16; ++t) {
            const f32x2 bu = *(const LAS f32x2*)(bufF + t * 132 + 2 * lane);
            const float nr = (lr * hr - li * hi) + bu[0], ni = (lr * hi + li * hr) + bu[1];
            hr = nr; hi = ni;
            hb[t * 68 + lane] = pk2(hr, hi);
        }
        asm volatile("s_waitcnt lgkmcnt(0)" ::: "memory");
        f32x4 y = (f32x4){0.f, 0.f, 0.f, 0.f};
#pragma unroll
        for (int kk = 0; kk < 4; ++kk) {
            const bf16x8 hf = *(const LAS bf16x8*)(hb + fr * 68 + kk * 16 + fq * 4);
            y = __builtin_amdgcn_mfma_f32_16x16x32_bf16(cm[kk], hf, y, 0, 0, 0);
        }
        asm volatile("s_waitcnt lgkmcnt(0)" ::: "memory");
        y[0] += dv[0] * lo16(udc.x); y[1] += dv[1] * hi16(udc.x); y[2] += dv[2] * lo16(udc.y); y[3] += dv[3] * hi16(udc.y);
        u32x2 zz; zz.x = pk2(gelu_tanh(y[0]), gelu_tanh(y[1])); zz.y = pk2(gelu_tanh(y[2]), gelu_tanh(y[3]));
        *(u32x2*)(Z + (size_t)(t0 + fr) * DR + g * 16 + fq * 4) = zz;
    }
    outr[lane] = hr; outi[lane] = hi;
}

__device__ void phase_scan(const Params& p, LAS unsigned char* lds) {
    const int blk = blockIdx.x, wave = threadIdx.x >> 6;
    LAS float* L = (LAS float*)lds;
    if (blk < 128) {
        const int b = blk >> 5, h = (blk >> 1) & 15, half = blk & 1;
        wkv_task(p, L, b * SEQ_P, SEQ_P, h, half, nullptr, p.out + O_WKVP + (size_t)(b * 16 + h) * 4096, nullptr);
    } else {
        for (int s = blk - 128; s < 1024; s += (int)gridDim.x - 128) {
            const int b = s >> 5, h = (s >> 1) & 15, half = s & 1;
            wkv_task(p, L, T_PR + b * SEQ_S, SEQ_S, h, half, p.in[3] + (size_t)(b * 16 + h) * 4096, p.out + O_WKVS + (size_t)(b * 16 + h) * 4096, p.in[2] + (size_t)b * NSH);
        }
        const int nb2 = (int)gridDim.x - 128, k = blk - 128;
        LAS unsigned char* wl = lds + wave * 12800;
        if (wave < 2) {
            for (int id = k * 2 + wave; id < 256; id += nb2 * 2) {
                const int b = id >> 6, g = id & 63;
                s5_task(p, wl, b * SEQ_P, SEQ_P, g, nullptr, nullptr, p.out + O_S5RP + (size_t)id * 64, p.out + O_S5IP + (size_t)id * 64);
            }
        } else {
            for (int id = k * 6 + (wave - 2); id < 2048; id += nb2 * 6) {
                const int b = id >> 6, g = id & 63;
                s5_task(p, wl, T_PR + b * SEQ_S, SEQ_S, g, p.in[4] + (size_t)id * 64, p.in[5] + (size_t)id * 64, p.out + O_S5RS + (size_t)id * 64, p.out + O_S5IS + (size_t)id * 64);
            }
        }
    }
    __syncthreads();
}

__device__ void phase_post(const Params& p) {
    const int lane = threadIdx.x & 63, gw = blockIdx.x * 8 + (threadIdx.x >> 6), NGW = gridDim.x * 8;
    const bf16_t* PROJ = (const bf16_t*)(p.ws + WS_PROJ);
    const bf16_t* AA = (const bf16_t*)((const unsigned char*)p.out + DO_A);
    const bf16_t* GG = (const bf16_t*)((const unsigned char*)p.out + DO_G);
    const bf16_t* YW = (const bf16_t*)(p.ws + WS_YW);
    bf16_t* O = (bf16_t*)(p.ws + WS_O);
    for (int it = gw; it < T_ALL * 16; it += NGW) {
        const int t = it >> 4, h = it & 15;
        const int cr = h * 64 + lane, ck = 1024 + cr, cv = 2048 + cr;
        const bf16_t* row = PROJ + (size_t)t * NINP;
        const float c_r = bf2f(row[cr]), c_k = bf2f(row[ck]), c_v = bf2f(row[cv]);
        float pr, pk, pv;
        if (!is_first(t)) { const bf16_t* prow = row - NINP; pr = bf2f(prow[cr]); pk = bf2f(prow[ck]); pv = bf2f(prow[cv]); }
        else if (t >= T_PR) { const float* cs = p.in[2] + (size_t)((t - T_PR) >> 6) * NSH; pr = cs[cr]; pk = cs[ck]; pv = cs[cv]; }
        else { pr = pk = pv = 0.f; }
        const float r = c_r + (pr - c_r) * p.in[9][cr], kx = c_k + (pk - c_k) * p.in[9][ck], v = c_v + (pv - c_v) * p.in[9][cv];
        const float a = bf2f(AA[(size_t)t * DR + cr]);
        const float g = bf2f(GG[(size_t)t * DR + cr]);
        const float kp = kx * (1.f + (a - 1.f) * p.in[16][cr]);
        const float bonus = wave_sum(r * kp * p.in[17][cr]) * v;
        const float y = bf2f(YW[(size_t)t * DR + cr]);
        const float mean = wave_sum(y) * (1.f / 64.f);
        const float d = y - mean;
        const float var = wave_sum(d * d) * (1.f / 64.f);
        const float yn = d * (1.f / sqrtf(var + GN_EPS)) * p.in[18][cr] + p.in[19][cr];
        O[(size_t)t * D + cr] = (bf16_t)f2bf((yn + bonus) * g);
    }
}

__device__ void phase_ln(const float* Y, const float* g, const float* b, bf16_t* xo, float* fo) {
    const int lane = threadIdx.x & 63, gw = blockIdx.x * 8 + (threadIdx.x >> 6), NGW = gridDim.x * 8;
    for (int t = gw; t < T_ALL; t += NGW) ln_row(Y + (size_t)t * D, g, b, xo ? xo + (size_t)t * D : nullptr, fo ? fo + (size_t)t * D : nullptr, lane);
}

constexpr int N_PHASES = 12;
__global__ void __launch_bounds__(512, 2) fwd_kernel(Params p) {
    extern __shared__ __attribute__((aligned(16))) unsigned char shm[];
    LAS unsigned char* lds = (LAS unsigned char*)shm;
    cg::grid_group grid = cg::this_grid();
    unsigned char* ws = p.ws;
    const int lo = p.ph_lo, hi = p.ph_hi;
#define IN(k) (lo <= (k) && (k) < hi)
#define REP(k) for (int rr_ = 0; rr_ <= ((PROBE_REP >> (k)) & 1); ++rr_)
#define SEAM(k) do { if (IN(k) && IN((k) + 1)) grid.sync(); } while (0)
    bf16_t* XN = (bf16_t*)(ws + WS_XN); bf16_t* PROJ = (bf16_t*)(ws + WS_PROJ); bf16_t* O = (bf16_t*)(ws + WS_O); bf16_t* Z = (bf16_t*)(ws + WS_Z);
    bf16_t* H = (bf16_t*)(ws + WS_H); bf16_t* LA = (bf16_t*)(ws + WS_LA);
    const int G = (int)gridDim.x, c = (int)blockIdx.x;

    if (IN(0)) REP(0) { phase_prep(p, lds); } SEAM(0);
    if (IN(1)) REP(1) {
        pg8::Gemm g{XN, (const bf16_t*)(ws + WS_WIN), T_ALL, NINP, D}; pg8::StaticOrder S; S.init(T_ALL, NINP, G, c);
        EpiProj E{PROJ, p.out}; pg8::gemm_phase<EpiProj, pg8::StaticOrder>(lds, g, S, E);
    } SEAM(1);
    if (IN(2)) REP(2) { phase_la(p); } SEAM(2);
    if (IN(3)) REP(3) {
        pg8::Gemm g{LA, (const bf16_t*)(ws + WS_WLORA), T_ALL, LORA_N, LORA_K}; pg8::StaticOrder S; S.init(T_ALL, LORA_N, G, c);
        EpiLora E{(float*)((unsigned char*)p.out + DO_DEC), (bf16_t*)((unsigned char*)p.out + DO_A), p.in[10], p.in[12]}; pg8::gemm_phase<EpiLora, pg8::StaticOrder>(lds, g, S, E);
    } SEAM(3);
    if (IN(4)) REP(4) { phase_scan(p, lds); } SEAM(4);
    if (IN(5)) REP(5) { phase_post(p); } SEAM(5);
    if (IN(6)) REP(6) {
        pg8::Gemm g{Z, (const bf16_t*)(ws + WS_WGLU), T_ALL, DR, DR}; pg8::StaticOrder S; S.init(T_ALL, DR, G, c);
        EpiGlu E{Z, O, p.in[29]}; pg8::gemm_phase<EpiGlu, pg8::StaticOrder>(lds, g, S, E);
    } SEAM(6);
    if (IN(7)) REP(7) {
        pg8::Gemm g{O, (const bf16_t*)(ws + WS_WOUT), T_ALL, D, D}; pg8::StaticOrder S; S.init(T_ALL, D, G, c);
        EpiRes E{XN, p.out}; pg8::gemm_phase<EpiRes, pg8::StaticOrder>(lds, g, S, E);
    } SEAM(7);
    if (IN(8)) REP(8) { phase_ln(p.out, p.in[31], p.in[32], XN, nullptr); } SEAM(8);
    if (IN(9)) REP(9) {
        pg8::Gemm g{XN, (const bf16_t*)(ws + WS_W13), T_ALL, 2 * DFF, D}; pg8::StaticOrder S; S.init(T_ALL, 2 * DFF, G, c);
        EpiFfn1 E{H}; pg8::gemm_phase<EpiFfn1, pg8::StaticOrder>(lds, g, S, E);
    } SEAM(9);
    if (IN(10)) REP(10) {
        pg8::Gemm g{H, (const bf16_t*)(ws + WS_W2), T_ALL, D, DFF}; pg8::StaticOrder S; S.init(T_ALL, D, G, c);
        EpiRes E{XN, p.out}; pg8::gemm_phase<EpiRes, pg8::StaticOrder>(lds, g, S, E);
    } SEAM(10);
    if (IN(11)) REP(11) { phase_ln(p.out, p.in[36], p.in[37], nullptr, p.out); }
#undef IN
#undef REP
#undef SEAM
}

#ifndef N_LAUNCHES
#define N_LAUNCHES 1
#endif
extern "C" void kernel_launch(void* const* d_in, const int* in_sizes, int n_in, void* d_out, int out_size, void* d_ws, size_t ws_size, hipStream_t stream) {
    static int ready = 0;
    if (!ready) {
        if (hipFuncSetAttribute((const void*)fwd_kernel, hipFuncAttributeMaxDynamicSharedMemorySize, LDS_BYTES) != hipSuccess) fprintf(stderr, "kernel_launch: hipFuncSetAttribute failed\n");
        int per_cu = 0; (void)hipOccupancyMaxActiveBlocksPerMultiprocessor(&per_cu, (const void*)fwd_kernel, 512, LDS_BYTES);
        if (per_cu < 1) fprintf(stderr, "kernel_launch: occupancy query says %d blocks per CU\n", per_cu);
        if (ws_size < WS_END) fprintf(stderr, "kernel_launch: workspace too small: %zu < %zu\n", ws_size, (size_t)WS_END);
        (void)hipGetLastError();
        ready = 1;
    }
    Params p{};
    for (int i = 0; i < 38; ++i) p.in[i] = (const float*)d_in[i];
    p.out = (float*)d_out; p.ws = (unsigned char*)d_ws;
    if (N_LAUNCHES == 1) {
        p.ph_lo = 0; p.ph_hi = N_PHASES;
        void* args[] = {&p};
        hipError_t e = hipLaunchCooperativeKernel((const void*)fwd_kernel, dim3(256), dim3(512), args, LDS_BYTES, stream);
        if (e != hipSuccess) fprintf(stderr, "kernel_launch: cooperative launch failed: %s\n", hipGetErrorString(e));
    } else {
        for (int ph = 0; ph < N_PHASES; ++ph) {
            p.ph_lo = ph; p.ph_hi = ph + 1;
            hipLaunchKernelGGL(fwd_kernel, dim3(256), dim3(512), LDS_BYTES, stream, p);
        }
    }
}
```
